# Optimizing an MI355X kernel written in HIP

```python
import math
import jax
import jax.numpy as jnp
from jax import lax
import numpy as np

D_MODEL = 1024
BATCH = 8
SEQ = 4096
DEPTH = 4

GRID_W = 64
CTX_LEN = 256
GROUP_W = 256
N_GROUPS = 4
MIX_W = GROUP_W * N_GROUPS
N_IN_SLICES = 14
IN_W = GROUP_W * N_IN_SLICES
LRU_HEADS = 4
LRU_BLOCK = GROUP_W // LRU_HEADS
LRU_CONV = 4
LRU_C = 8.0
HGRN_HEADS = 4
HGRN_HEAD_DIM = GROUP_W // HGRN_HEADS
HGRN_CHUNK = 64
LB_FLOOR = 1e-30
CONV_K = 31
DIFF_HEADS = 4
DIFF_HEAD_DIM = GROUP_W // (2 * DIFF_HEADS)
Q_BLOCK = 128
ROPE_THETA = 10000.0
RMS_EPS = 1e-6
LN_EPS = 1e-5

kernel_name = 'hybrid_parallel_heads_dit_block'


def rms_norm(x, g):
    xf = x.astype(jnp.float32)
    y = xf * lax.rsqrt(jnp.mean(xf * xf, axis=-1, keepdims=True) + RMS_EPS)
    return (y * g.astype(jnp.float32)).astype(x.dtype)


def layer_norm(x, g, b):
    xf = x.astype(jnp.float32)
    mu = jnp.mean(xf, axis=-1, keepdims=True)
    var = jnp.mean(jnp.square(xf - mu), axis=-1, keepdims=True)
    y = (xf - mu) * lax.rsqrt(var + LN_EPS) * g.astype(jnp.float32) + b.astype(jnp.float32)
    return y.astype(x.dtype)


def depthwise_conv(x, w, b, pad_left, pad_right):
    y = lax.conv_general_dilated(
        x, w[:, None, :].astype(x.dtype), window_strides=(1,),
        padding=[(pad_left, pad_right)], dimension_numbers=('NWC', 'WIO', 'NWC'),
        feature_group_count=x.shape[-1])
    return y + b.astype(x.dtype)


def axial_rope_tables(n_tokens):
    rows = n_tokens // GRID_W
    row = jnp.repeat(jnp.arange(rows, dtype=jnp.float32), GRID_W)
    col = jnp.tile(jnp.arange(GRID_W, dtype=jnp.float32), rows)
    n_freq = DIFF_HEAD_DIM // 4
    inv_freq = ROPE_THETA ** (-jnp.arange(n_freq, dtype=jnp.float32) / n_freq)
    ang = jnp.concatenate([row[:, None] * inv_freq, col[:, None] * inv_freq], axis=-1)
    return jnp.cos(ang), jnp.sin(ang)


def apply_rope(x, cos, sin):
    half = x.shape[-1] // 2
    x1, x2 = x[..., :half], x[..., half:]
    c = cos[None, :, None, :].astype(x.dtype)
    s = sin[None, :, None, :].astype(x.dtype)
    return jnp.concatenate([x1 * c - x2 * s, x1 * s + x2 * c], axis=-1)


def block_diag(x, w, b):
    bsz, l, _ = x.shape
    y = jnp.einsum('blhi,hij->blhj', x.reshape(bsz, l, LRU_HEADS, LRU_BLOCK), w)
    return y.reshape(bsz, l, GROUP_W) + b


def linear_scan(a, u, h0):
    def combine(left, right):
        return left[0] * right[0], right[0] * left[1] + right[1]
    a_cum, h = lax.associative_scan(combine, (a, u), axis=1)
    return h + a_cum * h0[:, None, :]


def rglru_direction(x_c, x_l, w_r, b_r, w_i, b_i, lam):
    def coeffs(x):
        xf = x.astype(jnp.float32)
        r = jax.nn.sigmoid(block_diag(xf, w_r, b_r))
        i = jax.nn.sigmoid(block_diag(xf, w_i, b_i))
        log_a = -LRU_C * r * jax.nn.softplus(-lam.astype(jnp.float32))
        return jnp.exp(log_a), jnp.sqrt(jnp.maximum(-jnp.expm1(2.0 * log_a), 0.0)) * (i * xf)
    a_c, u_c = coeffs(x_c)
    h_c = linear_scan(a_c, u_c, jnp.zeros_like(u_c[:, 0]))
    a_l, u_l = coeffs(x_l)
    h_l = linear_scan(a_l, u_l, h_c[:, -1])
    return h_c, h_l


def rglru_mixer(x_l, x_c, conv_w, conv_b, w_r, b_r, w_i, b_i, lam):
    pad_l, pad_r = LRU_CONV // 2, LRU_CONV - 1 - LRU_CONV // 2
    xc_l = depthwise_conv(x_l, conv_w, conv_b, pad_l, pad_r)
    xc_c = depthwise_conv(x_c, conv_w, conv_b, pad_l, pad_r)
    hf_c, hf_l = rglru_direction(xc_c, xc_l, w_r[0], b_r[0], w_i[0], b_i[0], lam[0])
    hb_c, hb_l = rglru_direction(jnp.flip(xc_c, 1), jnp.flip(xc_l, 1), w_r[1], b_r[1], w_i[1], b_i[1], lam[1])
    y_l = (hf_l + jnp.flip(hb_l, 1)).astype(x_l.dtype)
    y_c = (hf_c + jnp.flip(hb_c, 1)).astype(x_c.dtype)
    return y_l, y_c


def log_forget(z, lb):
    zf = z.astype(jnp.float32)
    lbf = lb.astype(jnp.float32)
    return jnp.logaddexp(jnp.log(jnp.maximum(lbf, LB_FLOOR)), jnp.log1p(-lbf) + jax.nn.log_sigmoid(zf))


def gla_chunk_scan(q, k, v, log_f, s0):
    b, l, h, _ = q.shape
    dv = v.shape[-1]
    n = l // HGRN_CHUNK

    def to_chunks(t):
        return t.astype(jnp.float32).reshape(b, n, HGRN_CHUNK, h, t.shape[-1]).transpose(1, 0, 3, 2, 4)

    incl = jnp.tril(jnp.ones((HGRN_CHUNK, HGRN_CHUNK), dtype=bool))[:, :, None]

    def step(state, chunk):
        qc, kc, vc, gc = chunk
        g_cum = jnp.cumsum(gc, axis=2)
        o_inter = jnp.einsum('bhcd,bhde->bhce', qc * jnp.exp(g_cum), state)
        rel = g_cum[:, :, :, None, :] - g_cum[:, :, None, :, :]
        decay = jnp.where(incl, jnp.exp(jnp.minimum(rel, 0.0)), 0.0)
        scores = jnp.einsum('bhid,bhjd,bhijd->bhij', qc, kc, decay)
        o = o_inter + jnp.einsum('bhij,bhje->bhie', scores, vc)
        g_end = g_cum[:, :, -1:, :]
        state = (jnp.exp(g_end[:, :, 0, :, None]) * state
                 + jnp.einsum('bhcd,bhce->bhde', kc * jnp.exp(g_end - g_cum), vc))
        return state, o

    state, o = lax.scan(step, s0.astype(jnp.float32), tuple(to_chunks(t) for t in (q, k, v, log_f)))
    return o.transpose(1, 0, 3, 2, 4).reshape(b, l, h, dv), state


def hgrn2_mixer(q_l, i_l, zf_l, zb_l, q_c, i_c, zf_c, zb_c, lb, norm_g):
    def heads(t):
        return t.reshape(t.shape[0], t.shape[1], HGRN_HEADS, HGRN_HEAD_DIM)
    bsz = q_l.shape[0]
    qh_l, qh_c = heads(jax.nn.silu(q_l)), heads(jax.nn.silu(q_c))
    ih_l, ih_c = heads(i_l), heads(i_c)
    outs_l, outs_c = [], []
    for d, (z_l, z_c) in enumerate(((zf_l, zf_c), (zb_l, zb_c))):
        g_l, g_c = heads(log_forget(z_l, lb[d])), heads(log_forget(z_c, lb[d]))
        seq_c = (qh_c, -jnp.expm1(g_c), ih_c, g_c)
        seq_l = (qh_l, -jnp.expm1(g_l), ih_l, g_l)
        if d == 1:
            seq_c = tuple(jnp.flip(t, 1) for t in seq_c)
            seq_l = tuple(jnp.flip(t, 1) for t in seq_l)
        s_zero = jnp.zeros((bsz, HGRN_HEADS, HGRN_HEAD_DIM, HGRN_HEAD_DIM), jnp.float32)
        o_c, s_c = gla_chunk_scan(*seq_c, s_zero)
        o_l, _ = gla_chunk_scan(*seq_l, s_c)
        if d == 1:
            o_c, o_l = jnp.flip(o_c, 1), jnp.flip(o_l, 1)
        outs_c.append(o_c)
        outs_l.append(o_l)

    def finish(o, like):
        return rms_norm(o, norm_g).reshape(o.shape[0], o.shape[1], GROUP_W).astype(like.dtype)
    return finish(outs_l[0] + outs_l[1], q_l), finish(outs_c[0] + outs_c[1], q_c)


def conformer_conv(v, g, w, b, ln_g, ln_b):
    y = v * jax.nn.sigmoid(g)
    y = depthwise_conv(y, w, b, CONV_K // 2, CONV_K // 2)
    return jax.nn.silu(layer_norm(y, ln_g, ln_b))


def diff_attention_mixer(q_l, k_l, v_l, q_c, k_c, v_c, cos, sin, lam, lam_init, norm_g, with_ctx):
    bsz, l, _ = q_l.shape
    h2 = 2 * DIFF_HEADS

    def sub_heads(t):
        return t.reshape(t.shape[0], t.shape[1], h2, DIFF_HEAD_DIM)

    def val_heads(t):
        return t.reshape(t.shape[0], t.shape[1], DIFF_HEADS, 2 * DIFF_HEAD_DIM)

    scale = DIFF_HEAD_DIM ** -0.5

    def attend(q, keys, vals):
        s = jnp.einsum('bqhd,bkhd->bhqk', q, keys).astype(jnp.float32) * scale
        p = jax.nn.softmax(s, axis=-1)
        p = p.reshape(p.shape[0], DIFF_HEADS, 2, p.shape[2], p.shape[3])
        a = (p[:, :, 0] - lam * p[:, :, 1]).astype(vals.dtype)
        return jnp.einsum('bhqk,bkhe->bqhe', a, vals)

    def finish(o):
        return (rms_norm(o, norm_g) * (1.0 - lam_init)).reshape(o.shape[0], o.shape[1], GROUP_W)

    kh_c, vh_c = sub_heads(k_c), val_heads(v_c)
    keys = jnp.concatenate([kh_c, apply_rope(sub_heads(k_l), cos, sin)], axis=1)
    vals = jnp.concatenate([vh_c, val_heads(v_l)], axis=1)
    n_blk = l // Q_BLOCK
    q_rot = apply_rope(sub_heads(q_l), cos, sin)
    q_blocks = q_rot.reshape(bsz, n_blk, Q_BLOCK, h2, DIFF_HEAD_DIM).transpose(1, 0, 2, 3, 4)
    o_l = lax.map(lambda qb: attend(qb, keys, vals), q_blocks)
    o_l = o_l.transpose(1, 0, 2, 3, 4).reshape(bsz, l, DIFF_HEADS, 2 * DIFF_HEAD_DIM)
    y_l = finish(o_l)
    y_c = finish(attend(sub_heads(q_c), kh_c, vh_c)) if with_ctx else None
    return y_l, y_c


def hybrid_layer(x, xc, c, c_ctx, layer, with_ctx, lb, cos, sin,
                 w_mod, b_mod, g_pre, g_post, w_in, w_out,
                 lru_conv_w, lru_conv_b, lru_w_r, lru_b_r, lru_w_i, lru_b_i, lru_lambda,
                 hgrn_norm_g, conf_conv_w, conf_conv_b, conf_ln_g, conf_ln_b,
                 lam_q1, lam_k1, lam_q2, lam_k2, diff_norm_g):
    mod = jax.nn.silu(c) @ w_mod + b_mod
    mod_c = jax.nn.silu(c_ctx) @ w_mod + b_mod
    shift, scale, gate = jnp.split(mod, 3, axis=-1)
    shift_c, scale_c, gate_c = jnp.split(mod_c, 3, axis=-1)
    h = rms_norm(x, g_pre) * (1.0 + scale[:, None]) + shift[:, None]
    hc = rms_norm(xc, g_pre) * (1.0 + scale_c) + shift_c
    u = jnp.split(h @ w_in, N_IN_SLICES, axis=-1)
    uc = jnp.split(hc @ w_in, N_IN_SLICES, axis=-1)

    ya, ya_c = rglru_mixer(u[0], uc[0], lru_conv_w, lru_conv_b, lru_w_r, lru_b_r, lru_w_i, lru_b_i, lru_lambda)
    yb, yb_c = hgrn2_mixer(u[2], u[3], u[4], u[5], uc[2], uc[3], uc[4], uc[5], lb, hgrn_norm_g)
    yc = conformer_conv(u[7], u[8], conf_conv_w, conf_conv_b, conf_ln_g, conf_ln_b)
    lam_init = 0.8 - 0.6 * math.exp(-0.3 * layer)
    lam = (jnp.exp(jnp.sum(lam_q1.astype(jnp.float32) * lam_k1.astype(jnp.float32)))
           - jnp.exp(jnp.sum(lam_q2.astype(jnp.float32) * lam_k2.astype(jnp.float32))) + lam_init)
    yd, yd_c = diff_attention_mixer(u[10], u[11], u[12], uc[10], uc[11], uc[12], cos, sin,
                                    lam, lam_init, diff_norm_g, with_ctx)

    def merge(ys, gs):
        return jnp.concatenate([y * jax.nn.silu(g) for y, g in zip(ys, gs)], axis=-1) @ w_out

    x = x + gate[:, None] * rms_norm(merge((ya, yb, yc, yd), (u[1], u[6], u[9], u[13])), g_post)
    if with_ctx:
        yc_c = conformer_conv(uc[7], uc[8], conf_conv_w, conf_conv_b, conf_ln_g, conf_ln_b)
        xc = xc + gate_c * rms_norm(merge((ya_c, yb_c, yc_c, yd_c), (uc[1], uc[6], uc[9], uc[13])), g_post)
    return x, xc


def setup_inputs(seed: int = 0) -> dict:
    key = jax.random.key(seed)
    ks = jax.random.split(key, 28)
    f32 = jnp.float32
    D = D_MODEL

    def nrm(k, shape, s):
        return jax.random.normal(k, shape, f32) * s

    a_pow = jax.random.uniform(ks[16], (DEPTH, 2, GROUP_W), f32, 0.9, 0.999)
    sig = a_pow ** (1.0 / LRU_C)
    return {
        'x': nrm(ks[0], (BATCH, SEQ, D), 1.0),
        'c': nrm(ks[1], (BATCH, D), 1.0),
        'ctx': nrm(ks[2], (BATCH, CTX_LEN, D), 1.0),
        'c_ctx': nrm(ks[3], (D,), 1.0),
        'w_mod': nrm(ks[4], (DEPTH, D, 3 * D), 0.5 * D ** -0.5),
        'b_mod': nrm(ks[5], (DEPTH, 3 * D), 0.02),
        'g_pre': 1.0 + nrm(ks[6], (DEPTH, D), 0.02),
        'g_post': 1.0 + nrm(ks[7], (DEPTH, D), 0.02),
        'w_in': nrm(ks[8], (DEPTH, D, IN_W), D ** -0.5),
        'w_out': nrm(ks[9], (DEPTH, MIX_W, D), MIX_W ** -0.5),
        'lru_conv_w': nrm(ks[10], (DEPTH, LRU_CONV, GROUP_W), LRU_CONV ** -0.5),
        'lru_conv_b': nrm(ks[11], (DEPTH, GROUP_W), 0.02),
        'lru_w_r': nrm(ks[12], (DEPTH, 2, LRU_HEADS, LRU_BLOCK, LRU_BLOCK), LRU_BLOCK ** -0.5),
        'lru_b_r': nrm(ks[13], (DEPTH, 2, GROUP_W), 0.02),
        'lru_w_i': nrm(ks[14], (DEPTH, 2, LRU_HEADS, LRU_BLOCK, LRU_BLOCK), LRU_BLOCK ** -0.5),
        'lru_b_i': nrm(ks[15], (DEPTH, 2, GROUP_W), 0.02),
        'lru_lambda': jnp.log(sig) - jnp.log1p(-sig),
        'hgrn_lb': nrm(ks[17], (DEPTH, 2, GROUP_W), 1.0),
        'hgrn_norm_g': 1.0 + nrm(ks[18], (DEPTH, HGRN_HEAD_DIM), 0.02),
        'conf_conv_w': nrm(ks[19], (DEPTH, CONV_K, GROUP_W), CONV_K ** -0.5),
        'conf_conv_b': nrm(ks[20], (DEPTH, GROUP_W), 0.02),
        'conf_ln_g': 1.0 + nrm(ks[21], (DEPTH, GROUP_W), 0.02),
        'conf_ln_b': nrm(ks[22], (DEPTH, GROUP_W), 0.02),
        'diff_lam_q1': nrm(ks[23], (DEPTH, DIFF_HEAD_DIM), 0.1),
        'diff_lam_k1': nrm(ks[24], (DEPTH, DIFF_HEAD_DIM), 0.1),
        'diff_lam_q2': nrm(ks[25], (DEPTH, DIFF_HEAD_DIM), 0.1),
        'diff_lam_k2': nrm(ks[26], (DEPTH, DIFF_HEAD_DIM), 0.1),
        'diff_norm_g': 1.0 + nrm(ks[27], (DEPTH, 2 * DIFF_HEAD_DIM), 0.02),
    }


def reference(x, c, ctx, c_ctx, w_mod, b_mod, g_pre, g_post, w_in, w_out,
              lru_conv_w, lru_conv_b, lru_w_r, lru_b_r, lru_w_i, lru_b_i, lru_lambda,
              hgrn_lb, hgrn_norm_g, conf_conv_w, conf_conv_b, conf_ln_g, conf_ln_b,
              diff_lam_q1, diff_lam_k1, diff_lam_q2, diff_lam_k2, diff_norm_g):
    cos, sin = axial_rope_tables(x.shape[1])
    p = jax.nn.softmax(hgrn_lb.astype(jnp.float32), axis=0)
    lower_bounds = jnp.cumsum(p, axis=0) - p[0]
    xc = ctx
    for layer in range(DEPTH):
        x, xc = hybrid_layer(
            x, xc, c, c_ctx, layer, layer < DEPTH - 1, lower_bounds[layer], cos, sin,
            w_mod[layer], b_mod[layer], g_pre[layer], g_post[layer], w_in[layer], w_out[layer],
            lru_conv_w[layer], lru_conv_b[layer], lru_w_r[layer], lru_b_r[layer],
            lru_w_i[layer], lru_b_i[layer], lru_lambda[layer],
            hgrn_norm_g[layer], conf_conv_w[layer], conf_conv_b[layer], conf_ln_g[layer], conf_ln_b[layer],
            diff_lam_q1[layer], diff_lam_k1[layer], diff_lam_q2[layer], diff_lam_k2[layer], diff_norm_g[layer])
    return x
```

```cpp
#include <hip/hip_runtime.h>
#include <hip/hip_cooperative_groups.h>
#include <cstdio>
namespace cg = cooperative_groups;

#define DI __device__ __forceinline__
typedef short bf16x8 __attribute__((ext_vector_type(8)));
typedef short s16x4 __attribute__((ext_vector_type(4)));
typedef float f32x4 __attribute__((ext_vector_type(4)));
typedef float f32x16 __attribute__((ext_vector_type(16)));
typedef float f32x2 __attribute__((ext_vector_type(2)));
typedef __bf16 bf16_2 __attribute__((ext_vector_type(2)));
typedef unsigned short u16;
typedef unsigned int u32;
typedef u32 u32x4 __attribute__((ext_vector_type(4)));
typedef u32 u32x2 __attribute__((ext_vector_type(2)));

constexpr int NB = 8, LCTX = 256, T = 4352, M = NB * T, D = 1024, NIN = 3584, DEPTH = 4, NCH = 68;
constexpr float QSCALE = 0.17677669529663687f * 1.4426950408889634f;

constexpr size_t WS_CTL = 0;
constexpr size_t WS_MOD = 65536;
constexpr size_t WS_COS = WS_MOD + 524288;
constexpr size_t WS_SIN = WS_COS + 262144;
constexpr size_t WS_LB = WS_SIN + 262144;
constexpr size_t WS_LAM = WS_LB + 8192;
constexpr size_t WS_WIN = WS_LAM + 8192;
constexpr size_t WS_WOUT = WS_WIN + (size_t)4 * 3584 * 1024 * 2;
constexpr size_t WS_WL = WS_WOUT + (size_t)4 * 1024 * 1024 * 2;
constexpr size_t WS_XC = WS_WL + 524288;
constexpr size_t WS_H = WS_XC + (size_t)8 * 256 * 1024 * 4;
constexpr size_t WS_U = WS_H + (size_t)M * 1024 * 2;
constexpr size_t WS_SB = WS_U + (size_t)M * 3584 * 2;
constexpr size_t WS_DB = WS_SB + (size_t)64 * 68 * 4096 * 4;
constexpr size_t WS_LS = WS_DB + (size_t)64 * 68 * 64 * 4;
constexpr size_t WS_END = WS_LS + (size_t)8 * 2 * 68 * 256 * 8;

constexpr int LDS_BYTES = 73728;

struct Params {
  const float *x, *c, *ctx, *c_ctx, *w_mod, *b_mod, *g_pre, *g_post, *w_in, *w_out,
      *lru_conv_w, *lru_conv_b, *lru_w_r, *lru_b_r, *lru_w_i, *lru_b_i, *lru_lambda,
      *hgrn_lb, *hgrn_norm_g, *conf_conv_w, *conf_conv_b, *conf_ln_g, *conf_ln_b,
      *lam_q1, *lam_k1, *lam_q2, *lam_k2, *diff_norm_g;
  float* out;
  unsigned char* ws;
};

DI u32 pk(float lo, float hi) { f32x2 v = {lo, hi}; bf16_2 r = __builtin_convertvector(v, bf16_2); return __builtin_bit_cast(u32, r); }
DI u16 f2bf(float x) { return (u16)(pk(x, 0.f) & 0xffffu); }
DI float bf2f(u16 h) { return __uint_as_float(((u32)h) << 16); }
DI float bflo(u32 v) { return __uint_as_float(v << 16); }
DI float bfhi(u32 v) { return __uint_as_float(v & 0xffff0000u); }
DI bf16x8 mk8(u32 a, u32 b, u32 c, u32 d) { u32x4 v = {a, b, c, d}; return __builtin_bit_cast(bf16x8, v); }
DI s16x4 mk4(u32 a, u32 b) { u32x2 v = {a, b}; return __builtin_bit_cast(s16x4, v); }
DI float sigm(float x) { return __builtin_amdgcn_rcpf(1.f + __expf(-x)); }
DI float silu(float x) { return x * __builtin_amdgcn_rcpf(1.f + __expf(-x)); }
DI int otid() { int t = threadIdx.x; asm volatile("" : "+v"(t)); return t; }
DI float shx(float v, int o) { int ln = otid() & 63; return __int_as_float(__builtin_amdgcn_ds_bpermute((ln ^ o) << 2, __float_as_int(v))); }
DI float wave_sum(float v) {
#pragma unroll
  for (int o = 32; o > 0; o >>= 1) v += shx(v, o);
  return v;
}
DI s16x4 tr16(const u16* p) {
  return __builtin_amdgcn_ds_read_tr16_b64_v4i16((__attribute__((address_space(3))) s16x4*)p);
}
#define MFMA16(a, b, c) __builtin_amdgcn_mfma_f32_16x16x32_bf16((a), (b), (c), 0, 0, 0)
DI f32x4 mfma16k16_pad(s16x4 a, s16x4 b, f32x4 c) {
  const s16x4 z = {0, 0, 0, 0};
  return __builtin_amdgcn_mfma_f32_16x16x32_bf16(__builtin_shufflevector(a, z, 0, 1, 2, 3, 4, 5, 6, 7), __builtin_shufflevector(b, z, 0, 1, 2, 3, 4, 5, 6, 7), c, 0, 0, 0);
}
#define MFMA16K16(a, b, c) mfma16k16_pad((a), (b), (c))
#define MFMA32(a, b, c) __builtin_amdgcn_mfma_f32_32x32x16_bf16((a), (b), (c), 0, 0, 0)


#define XB_TMO      128
#define XB_XCNT(j)  (256  + 64 * (j))
#define XB_XSUB(j)  (1280 + 64 * (j))
#define XB_XGEN(j)  (2304 + 64 * (j))
#define XB_TOP      3328
#define XB_TOPGEN   3392
#define XCD_BAR_WORDS 3456
#define XB_SPIN_CAP (1u << 22)
#define LAS __attribute__((address_space(3)))
DI unsigned xb_ld(unsigned* p) { return __hip_atomic_load(p, __ATOMIC_RELAXED, __HIP_MEMORY_SCOPE_AGENT); }
DI unsigned xb_add(unsigned* p, unsigned v) { return __hip_atomic_fetch_add(p, v, __ATOMIC_RELAXED, __HIP_MEMORY_SCOPE_AGENT); }
DI unsigned xb_xcc_id() { return (unsigned)__builtin_amdgcn_s_getreg((3 << 11) | 20) & 0xFu; }
#define XB_SPIN(cond, bar) do { unsigned _sp = 0; while (cond) { __builtin_amdgcn_s_sleep(1); \
    if ((++_sp & 255u) == 0u) { if (xb_ld(&(bar)[XB_TMO])) break; if (_sp > XB_SPIN_CAP) { atomicAdd(&(bar)[XB_TMO], 1u); break; } } } } while (0)
struct XcdBarrier { unsigned* bar; unsigned x; volatile LAS unsigned* st; };
DI XcdBarrier xcd_barrier_post(unsigned* bar, volatile LAS unsigned* st) {
  XcdBarrier b; b.bar = bar; b.x = xb_xcc_id(); b.st = st;
  if (threadIdx.x == 0) (void)xb_add(&bar[XB_XCNT(b.x)], 1u);
  return b;
}
DI void xcd_barrier_complete(unsigned* bar, unsigned x, unsigned& nloc, unsigned& nx) {
  const unsigned G = gridDim.x * gridDim.y * gridDim.z;
  unsigned sum, cnt, mine, sp = 0u;
  for (;;) {
    sum = 0u; cnt = 0u; mine = 0u;
#pragma unroll
    for (unsigned j = 0; j < 16; ++j) { const unsigned c = xb_ld(&bar[XB_XCNT(j)]); sum += c; cnt += (c > 0u) ? 1u : 0u; mine = (j == x) ? c : mine; }
    if (sum == G) break;
    __builtin_amdgcn_s_sleep(1);
    if ((++sp & 255u) == 0u) { if (xb_ld(&bar[XB_TMO])) break; if (sp > XB_SPIN_CAP) { atomicAdd(&bar[XB_TMO], 1u); break; } }
  }
  nloc = mine > 0u ? mine : 1u; nx = cnt > 0u ? cnt : 1u;
}
DI void xcd_barrier(unsigned* bar_in, volatile LAS unsigned* st_in) {
  XcdBarrier b; b.bar = bar_in; b.x = xb_xcc_id(); b.st = st_in;
  asm volatile("s_waitcnt vmcnt(0)" ::: "memory");
  __syncthreads();
  if (threadIdx.x == 0) {
    unsigned* bar = b.bar;
    __builtin_amdgcn_s_waitcnt(0);
    unsigned nloc = b.st[0], nx = b.st[1];
    if (nloc == 0u) { xcd_barrier_complete(bar, b.x, nloc, nx); b.st[0] = nloc; b.st[1] = nx; }
    const unsigned old = xb_add(&bar[XB_XSUB(b.x)], 1u);
    const unsigned gen = old / nloc;
    if (old + 1u == (gen + 1u) * nloc) {
      __builtin_amdgcn_fence(__ATOMIC_RELEASE, "agent");
      asm volatile("s_waitcnt vmcnt(0)" ::: "memory");
      const unsigned og = xb_add(&bar[XB_TOP], 1u);
      const unsigned tg = og / nx;
      if (og + 1u == (tg + 1u) * nx) xb_add(&bar[XB_TOPGEN], 1u);
      else XB_SPIN(xb_ld(&bar[XB_TOPGEN]) == tg, bar);
      __builtin_amdgcn_fence(__ATOMIC_ACQUIRE, "agent");
      xb_add(&bar[XB_XGEN(b.x)], 1u);
      asm volatile("s_waitcnt vmcnt(0)" ::: "memory");
    } else {
      XB_SPIN(xb_ld(&bar[XB_XGEN(b.x)]) == gen, bar);
      __builtin_amdgcn_fence(__ATOMIC_ACQUIRE, "agent");
      asm volatile("s_waitcnt vmcnt(0)" ::: "memory");
    }
  }
  __syncthreads();
}

DI void transpose_cvt(const float* src, int ld_src, u16* dst, int ld_dst, float* tile) {
  const int tid = otid();
#pragma unroll
  for (int i = 0; i < 4; ++i) {
    int r = (tid >> 4) + 16 * i, c4 = (tid & 15) * 4;
    float4 v = *(const float4*)(src + (size_t)r * ld_src + c4);
    tile[r * 65 + c4] = v.x; tile[r * 65 + c4 + 1] = v.y; tile[r * 65 + c4 + 2] = v.z; tile[r * 65 + c4 + 3] = v.w;
  }
  __syncthreads();
  int n = tid >> 2, kq = (tid & 3) * 16;
  u32 pkv[8];
#pragma unroll
  for (int j = 0; j < 8; ++j) pkv[j] = pk(tile[(kq + 2 * j) * 65 + n], tile[(kq + 2 * j + 1) * 65 + n]);
  uint4* d = (uint4*)(dst + (size_t)n * ld_dst + kq);
  d[0] = make_uint4(pkv[0], pkv[1], pkv[2], pkv[3]);
  d[1] = make_uint4(pkv[4], pkv[5], pkv[6], pkv[7]);
  __syncthreads();
}

DI void phase_prologue(const Params& p, unsigned char* smem) {
  const int tid = otid();
  constexpr int N_WIN = 4 * 16 * 56, N_WOUT = 4 * 16 * 16, N_WL = 64, N_MOD = 4 * 96, N_ROPE = 256, N_LB = 1;
  constexpr int TOTAL = N_WIN + N_WOUT + N_WL + N_MOD + N_ROPE + N_LB;
  float* fs = (float*)smem;
  for (int it = blockIdx.x; it < TOTAL; it += gridDim.x) {
    int i = it;
    if (i < N_WIN) {
      int l = i / (16 * 56), r = i % (16 * 56), kt = r / 56, nt = r % 56;
      transpose_cvt(p.w_in + (size_t)l * 1024 * NIN + (size_t)kt * 64 * NIN + nt * 64, NIN,
                    (u16*)(p.ws + WS_WIN) + (size_t)l * NIN * 1024 + (size_t)nt * 64 * 1024 + kt * 64, 1024, fs);
      continue;
    }
    i -= N_WIN;
    if (i < N_WOUT) {
      int l = i / 256, r = i % 256, kt = r / 16, nt = r % 16;
      transpose_cvt(p.w_out + (size_t)l * 1024 * 1024 + (size_t)kt * 64 * 1024 + nt * 64, 1024,
                    (u16*)(p.ws + WS_WOUT) + (size_t)l * 1024 * 1024 + (size_t)nt * 64 * 1024 + kt * 64, 1024, fs);
      continue;
    }
    i -= N_WOUT;
    if (i < N_WL) {
      int head = i & 3, which = (i >> 2) & 1, ld = i >> 3;
      const float* src = (which ? p.lru_w_i : p.lru_w_r) + ((size_t)ld * 4 + head) * 4096;
      transpose_cvt(src, 64, (u16*)(p.ws + WS_WL) + (size_t)i * 4096, 64, fs);
      continue;
    }
    i -= N_WL;
    if (i < N_MOD) {
      int l = i / 96, cg = i % 96;
      float* sv = fs;
      float* red = fs + 9216;
      __syncthreads();
      for (int idx = tid; idx < 9216; idx += 256) {
        int m = idx >> 10, k = idx & 1023;
        float v = (m < 8) ? p.c[m * 1024 + k] : p.c_ctx[k];
        sv[idx] = silu(v);
      }
      __syncthreads();
      int cl = tid & 31, kg = tid >> 5, col = cg * 32 + cl;
      float acc[9];
#pragma unroll
      for (int m = 0; m < 9; ++m) acc[m] = 0.f;
      const float* wp = p.w_mod + (size_t)l * 1024 * 3072 + col;
#pragma unroll 4
      for (int k = kg * 128; k < kg * 128 + 128; ++k) {
        float w = wp[(size_t)k * 3072];
#pragma unroll
        for (int m = 0; m < 9; ++m) acc[m] += sv[m * 1024 + k] * w;
      }
#pragma unroll
      for (int m = 0; m < 9; ++m) red[(kg * 9 + m) * 32 + cl] = acc[m];
      __syncthreads();
      for (int o = tid; o < 288; o += 256) {
        int m = o >> 5, c2 = o & 31, col2 = cg * 32 + c2;
        float s = p.b_mod[l * 3072 + col2];
#pragma unroll
        for (int g = 0; g < 8; ++g) s += red[(g * 9 + m) * 32 + c2];
        ((float*)(p.ws + WS_MOD))[(l * 9 + m) * 3072 + col2] = s;
      }
      __syncthreads();
      continue;
    }
    i -= N_MOD;
    if (i < N_ROPE) {
      int idx = i * 256 + tid, pos = idx >> 4, j = idx & 15, f = j & 7;
      float inv = powf(10000.f, -(float)f / 8.f);
      float pp = (j < 8) ? (float)(pos >> 6) : (float)(pos & 63);
      float ang = pp * inv;
      ((float*)(p.ws + WS_COS))[idx] = cosf(ang);
      ((float*)(p.ws + WS_SIN))[idx] = sinf(ang);
      continue;
    }
    i -= N_ROPE;
    {
      float* lbo = (float*)(p.ws + WS_LB);
      for (int idx = tid; idx < 512; idx += 256) {
        float v[4], mx = -1e30f;
#pragma unroll
        for (int l = 0; l < 4; ++l) { v[l] = p.hgrn_lb[l * 512 + idx]; mx = fmaxf(mx, v[l]); }
        float s = 0.f;
#pragma unroll
        for (int l = 0; l < 4; ++l) { v[l] = expf(v[l] - mx); s += v[l]; }
        float cum = 0.f;
        lbo[idx] = 0.f;
#pragma unroll
        for (int l = 1; l < 4; ++l) { cum += v[l] / s; lbo[l * 512 + idx] = cum; }
      }
      if (tid < 4) {
        int l = tid;
        float s1 = 0.f, s2 = 0.f;
        for (int k = 0; k < 32; ++k) { s1 += p.lam_q1[l * 32 + k] * p.lam_k1[l * 32 + k]; s2 += p.lam_q2[l * 32 + k] * p.lam_k2[l * 32 + k]; }
        float li = 0.8f - 0.6f * expf(-0.3f * (float)l);
        float* lo = (float*)(p.ws + WS_LAM);
        lo[l * 2] = expf(s1) - expf(s2) + li;
        lo[l * 2 + 1] = 1.f - li;
      }
    }
  }
}

DI void phase_norm(const Params& p, int l) {
  const int tid = otid(); const int lane = tid & 63, gw = blockIdx.x * 4 + (tid >> 6), nw = gridDim.x * 4;
  const float* modp = (const float*)(p.ws + WS_MOD);
  const u16* Obuf = (const u16*)(p.ws + WS_U);
  u16* H = (u16*)(p.ws + WS_H);
  float* XC = (float*)(p.ws + WS_XC);
  for (int row = gw; row < M; row += nw) {
    int b = row / T, t = row - b * T;
    bool isctx = t < LCTX;
    int bm = isctx ? 8 : b;
    if (l == DEPTH && isctx) continue;
    float* xout;
    const float* xin;
    if (isctx) { xout = XC + ((size_t)b * 256 + t) * 1024; xin = (l <= 1) ? p.ctx + ((size_t)b * 256 + t) * 1024 : xout; }
    else { xout = p.out + ((size_t)b * 4096 + (t - 256)) * 1024; xin = (l <= 1) ? p.x + ((size_t)b * 4096 + (t - 256)) * 1024 : xout; }
    float4 xv[4];
#pragma unroll
    for (int j = 0; j < 4; ++j) xv[j] = *(const float4*)(xin + lane * 4 + 256 * j);
    if (l > 0) {
      const u16* O = Obuf + (size_t)row * 1024;
      float4 ov[4];
      float ss = 0.f;
#pragma unroll
      for (int j = 0; j < 4; ++j) {
        uint2 o2 = *(const uint2*)(O + lane * 4 + 256 * j);
        ov[j] = make_float4(bflo(o2.x), bfhi(o2.x), bflo(o2.y), bfhi(o2.y));
        ss += ov[j].x * ov[j].x + ov[j].y * ov[j].y + ov[j].z * ov[j].z + ov[j].w * ov[j].w;
      }
      ss = wave_sum(ss);
      float rs = rsqrtf(ss * (1.f / 1024.f) + 1e-6f);
      const float* gate = modp + ((l - 1) * 9 + bm) * 3072 + 2048;
      const float* gp = p.g_post + (l - 1) * 1024;
      float4 g4s[4], w4s[4];
#pragma unroll
      for (int j = 0; j < 4; ++j) { g4s[j] = *(const float4*)(gate + lane * 4 + 256 * j); w4s[j] = *(const float4*)(gp + lane * 4 + 256 * j); }
#pragma unroll
      for (int j = 0; j < 4; ++j) {
        int col = lane * 4 + 256 * j;
        const float4 g4 = g4s[j], w4 = w4s[j];
        xv[j].x += g4.x * (ov[j].x * rs * w4.x); xv[j].y += g4.y * (ov[j].y * rs * w4.y);
        xv[j].z += g4.z * (ov[j].z * rs * w4.z); xv[j].w += g4.w * (ov[j].w * rs * w4.w);
        *(float4*)(xout + col) = xv[j];
      }
    }
    if (l < DEPTH) {
      float ss = 0.f;
#pragma unroll
      for (int j = 0; j < 4; ++j) ss += xv[j].x * xv[j].x + xv[j].y * xv[j].y + xv[j].z * xv[j].z + xv[j].w * xv[j].w;
      ss = wave_sum(ss);
      float rs = rsqrtf(ss * (1.f / 1024.f) + 1e-6f);
      const float* shift = modp + (l * 9 + bm) * 3072;
      const float* scale = shift + 1024;
      const float* gpre = p.g_pre + l * 1024;
      float4 s4s[4], c4s[4], q4s[4];
#pragma unroll
      for (int j = 0; j < 4; ++j) { int col = lane * 4 + 256 * j; s4s[j] = *(const float4*)(shift + col); c4s[j] = *(const float4*)(scale + col); q4s[j] = *(const float4*)(gpre + col); }
#pragma unroll
      for (int j = 0; j < 4; ++j) {
        int col = lane * 4 + 256 * j;
        const float4 s4 = s4s[j], c4 = c4s[j], g4 = q4s[j];
        float h0 = xv[j].x * rs * g4.x * (1.f + c4.x) + s4.x, h1 = xv[j].y * rs * g4.y * (1.f + c4.y) + s4.y;
        float h2 = xv[j].z * rs * g4.z * (1.f + c4.z) + s4.z, h3 = xv[j].w * rs * g4.w * (1.f + c4.w) + s4.w;
        *(uint2*)(H + (size_t)row * 1024 + col) = make_uint2(pk(h0, h1), pk(h2, h3));
      }
    }
  }
}

DI void g_load(u32x4 (&rw)[4], u32x4 (&rx)[4], const u16* Wb, const u16* Xb, unsigned off) {
#pragma unroll
  for (int i = 0; i < 4; ++i) {
    rw[i] = *(const u32x4*)(Wb + (off + (unsigned)i * 32u * 1024u));
    rx[i] = *(const u32x4*)(Xb + (off + (unsigned)i * 32u * 1024u));
  }
}
DI void g_store(u16* sWs, u16* sXs, const u32x4 (&rw)[4], const u32x4 (&rx)[4]) {
#pragma unroll
  for (int i = 0; i < 4; ++i) {
    *(u32x4*)(sWs + i * 32 * 64) = rw[i];
    *(u32x4*)(sXs + i * 32 * 64) = rx[i];
  }
}
DI void g_compute(f32x4 (&acc)[4][4], const u16* cw, const u16* cx, int c0) {
  bf16x8 a0[4], b0[4], a1[4], b1[4];
#pragma unroll
  for (int i = 0; i < 4; ++i) { a0[i] = *(const bf16x8*)(cw + i * 16 * 64 + c0); b0[i] = *(const bf16x8*)(cx + i * 16 * 64 + c0); }
#pragma unroll
  for (int i = 0; i < 4; ++i) { a1[i] = *(const bf16x8*)(cw + i * 16 * 64 + (c0 ^ 32)); b1[i] = *(const bf16x8*)(cx + i * 16 * 64 + (c0 ^ 32)); }
#pragma unroll
  for (int ni = 0; ni < 4; ++ni)
#pragma unroll
    for (int mi = 0; mi < 4; ++mi) acc[ni][mi] = MFMA16(a0[ni], b0[mi], acc[ni][mi]);
#pragma unroll
  for (int ni = 0; ni < 4; ++ni)
#pragma unroll
    for (int mi = 0; mi < 4; ++mi) acc[ni][mi] = MFMA16(a1[ni], b1[mi], acc[ni][mi]);
}

template <int MODE>
DI void phase_gemm(const Params& p, int l, unsigned char* smem) {
  constexpr int NT = (MODE == 0) ? 28 : 8, MT = M / 128;
  const u16* Wt = (MODE == 0) ? (const u16*)(p.ws + WS_WIN) + (size_t)l * NIN * 1024 : (const u16*)(p.ws + WS_WOUT) + (size_t)l * 1024 * 1024;
  const u16* X = (const u16*)(p.ws + WS_H);
  u16* sW = (u16*)smem;
  u16* sX = sW + 2 * 128 * 64;
  const int tid = otid(), lane = tid & 63, w = tid >> 6, wn = w & 1, wm = w >> 1, r16 = lane & 15, q = lane >> 4;
  const float* lbp = (const float*)(p.ws + WS_LB) + l * 512;
  const float* cosp = (const float*)(p.ws + WS_COS);
  const float* sinp = (const float*)(p.ws + WS_SIN);
  const int xcd = blockIdx.x & 7, slot = blockIdx.x >> 3, nslots = gridDim.x >> 3;
  constexpr int PER_XCD = 34 * NT, NG = (MODE == 0) ? 7 : 8;
  for (int ti = slot; ti < PER_XCD; ti += nslots) {
    const int g = ti / (34 * NG), r = ti % (34 * NG), ml = r / NG, nl = r % NG;
    const int nt = g * NG + nl, mt = xcd * 34 + ml, n0 = nt * 128, m0 = mt * 128;
    f32x4 acc[4][4];
#pragma unroll
    for (int a = 0; a < 4; ++a)
#pragma unroll
      for (int b2 = 0; b2 < 4; ++b2) acc[a][b2] = (f32x4){0.f, 0.f, 0.f, 0.f};
    const int srow = tid >> 3, scc = tid & 7;
    const u16* Wp = Wt + (size_t)n0 * 1024;
    const u16* Xp = X + (size_t)m0 * 1024;
    const unsigned goff = (unsigned)(srow * 1024 + scc * 8);
    u16* sWs = sW + srow * 64 + ((scc ^ (srow & 7)) * 8);
    u16* sXs = sX + srow * 64 + ((scc ^ (srow & 7)) * 8);
    const u16* cw = sW + (wn * 64 + r16) * 64;
    const u16* cx = sX + (wm * 64 + r16) * 64;
    const int c0 = (q ^ (r16 & 7)) * 8;
    u32x4 r0w[4], r0x[4], r1w[4], r1x[4];
    g_load(r0w, r0x, Wp, Xp, goff);
    g_load(r1w, r1x, Wp, Xp, goff + 64u);
    g_store(sWs, sXs, r0w, r0x);
    g_load(r0w, r0x, Wp, Xp, goff + 128u);
    __syncthreads();
#pragma unroll 1
    for (int ks = 0; ks < 16; ks += 2) {
      g_store(sWs + 128 * 64, sXs + 128 * 64, r1w, r1x);
      if (ks + 3 < 16) g_load(r1w, r1x, Wp, Xp, goff + (unsigned)(ks + 3) * 64u);
      g_compute(acc, cw, cx, c0);
      __syncthreads();
      if (ks + 2 < 16) g_store(sWs, sXs, r0w, r0x);
      if (ks + 4 < 16) g_load(r0w, r0x, Wp, Xp, goff + (unsigned)(ks + 4) * 64u);
      g_compute(acc, cw + 128 * 64, cx + 128 * 64, c0);
      __syncthreads();
    }
    if (MODE == 1) {
      u16* O = (u16*)(p.ws + WS_U);
      u16* hT = (u16*)smem;
#pragma unroll
      for (int mi = 0; mi < 4; ++mi) {
        int ml = wm * 64 + mi * 16 + r16;
#pragma unroll
        for (int ni = 0; ni < 4; ++ni) {
          int nl2 = wn * 64 + ni * 16 + q * 4;
          *(uint2*)(hT + ml * 136 + nl2) = make_uint2(pk(acc[ni][mi][0], acc[ni][mi][1]), pk(acc[ni][mi][2], acc[ni][mi][3]));
        }
      }
      __syncthreads();
#pragma unroll
      for (int j = 0; j < 8; ++j) {
        int id = tid + 256 * j, row = id >> 4, c = id & 15;
        *(uint4*)(O + (size_t)(m0 + row) * 1024 + n0 + c * 8) = *(const uint4*)(hT + row * 136 + c * 8);
      }
      __syncthreads();
    } else {
      u16* U = (u16*)(p.ws + WS_U);
      const int slice = n0 >> 8;
#pragma unroll
      for (int mi = 0; mi < 4; ++mi) {
        int m = m0 + wm * 64 + mi * 16 + r16;
        int b = m / T, t = m - b * T;
        u16* urow = (u16*)smem + (wm * 64 + mi * 16 + r16) * 136 + wn * 64 + q * 4;
        if (slice == 10 || slice == 11) {
          bool rot = t >= LCTX;
          float4 cs = make_float4(1.f, 1.f, 1.f, 1.f), sn = make_float4(0.f, 0.f, 0.f, 0.f);
          if (rot) { cs = *(const float4*)(cosp + (t - LCTX) * 16 + q * 4); sn = *(const float4*)(sinp + (t - LCTX) * 16 + q * 4); }
          float sc = (slice == 10) ? QSCALE : 1.f;
          float csv[4] = {cs.x, cs.y, cs.z, cs.w}, snv[4] = {sn.x, sn.y, sn.z, sn.w};
#pragma unroll
          for (int hp = 0; hp < 2; ++hp) {
            float o1[4], o2[4];
#pragma unroll
            for (int i = 0; i < 4; ++i) {
              float x1 = acc[2 * hp][mi][i], x2 = acc[2 * hp + 1][mi][i];
              o1[i] = (x1 * csv[i] - x2 * snv[i]) * sc;
              o2[i] = (x1 * snv[i] + x2 * csv[i]) * sc;
            }
            *(uint2*)(urow + (2 * hp) * 16) = make_uint2(pk(o1[0], o1[1]), pk(o1[2], o1[3]));
            *(uint2*)(urow + (2 * hp + 1) * 16) = make_uint2(pk(o2[0], o2[1]), pk(o2[2], o2[3]));
          }
        } else {
#pragma unroll
          for (int ni = 0; ni < 4; ++ni) {
            float v[4];
#pragma unroll
            for (int i = 0; i < 4; ++i) v[i] = acc[ni][mi][i];
            if (slice == 1 || slice == 2 || slice == 6 || slice == 9 || slice == 13) {
#pragma unroll
              for (int i = 0; i < 4; ++i) v[i] = silu(v[i]);
            } else if (slice == 8) {
#pragma unroll
              for (int i = 0; i < 4; ++i) v[i] = sigm(v[i]);
            } else if (slice == 4 || slice == 5) {
              int cidx = (n0 & 255) + wn * 64 + ni * 16 + q * 4;
              float4 lb4 = *(const float4*)(lbp + (slice - 4) * 256 + cidx);
              float lbv[4] = {lb4.x, lb4.y, lb4.z, lb4.w};
#pragma unroll
              for (int i = 0; i < 4; ++i) {
                float f = fmaxf(lbv[i], 1e-30f) + (1.f - lbv[i]) * sigm(v[i]);
                v[i] = __logf(f);
              }
            }
            *(uint2*)(urow + ni * 16) = make_uint2(pk(v[0], v[1]), pk(v[2], v[3]));
          }
        }
      }
      __syncthreads();
#pragma unroll
      for (int j = 0; j < 8; ++j) {
        int id = tid + 256 * j, row = id >> 4, c = id & 15;
        *(uint4*)(U + (size_t)(m0 + row) * NIN + n0 + c * 8) = *(const uint4*)((const u16*)smem + row * 136 + c * 8);
      }
      __syncthreads();
    }
  }
}

DI float vmax3(float a, float b, float c) { float r; asm("v_max3_f32 %0, %1, %2, %3" : "=v"(r) : "v"(a), "v"(b), "v"(c)); return r; }
DI void attn_sub(const u16* cK, const u16* cV, int shoff, int h, int r32, int tr_row, int tr_col,
                 const bf16x8& q0, const bf16x8& q1, f32x16& oa0, f32x16& oa1, float& mref, float& lrun, bool first) {
  f32x16 S0, S1;
  {
    const u16* kp = cK + r32 * 72 + shoff + 8 * h;
    bf16x8 k0 = *(const bf16x8*)(kp), k1 = *(const bf16x8*)(kp + 16);
    bf16x8 k2 = *(const bf16x8*)(kp + 32 * 72), k3 = *(const bf16x8*)(kp + 32 * 72 + 16);
    f32x16 z;
    const float nm = -mref;
#pragma unroll
    for (int i = 0; i < 16; ++i) z[i] = nm;
    S0 = MFMA32(k0, q0, z); S0 = MFMA32(k1, q1, S0);
    S1 = MFMA32(k2, q0, z); S1 = MFMA32(k3, q1, S1);
  }
  float s00 = S0[0], s10 = S1[0];
  asm volatile("s_nop 7\n\ts_nop 7\n\ts_nop 3" : "+v"(s00), "+v"(s10));
  float mx = vmax3(s00, s10, S0[1]);
#pragma unroll
  for (int i = 2; i < 16; i += 2) mx = vmax3(mx, S0[i], S0[i + 1]);
  mx = vmax3(mx, S1[1], S1[2]);
#pragma unroll
  for (int i = 3; i < 15; i += 2) mx = vmax3(mx, S1[i], S1[i + 1]);
  mx = fmaxf(mx, S1[15]);
  mx = fmaxf(mx, shx(mx, 32));
  const bool need = first || (mx > 8.f);
  if (__builtin_amdgcn_ballot_w64(need) != 0ull) {
    const float delta = first ? mx : fmaxf(mx, 0.f);
    mref += delta;
    if (!first) {
      const float al = __builtin_amdgcn_exp2f(-delta);
      lrun *= al;
#pragma unroll
      for (int i = 0; i < 16; ++i) { oa0[i] *= al; oa1[i] *= al; }
    }
#pragma unroll
    for (int i = 0; i < 16; ++i) { S0[i] -= delta; S1[i] -= delta; }
  }
  f32x2 rs2 = {0.f, 0.f};
#pragma unroll
  for (int i = 0; i < 16; i += 2) {
    S0[i] = __builtin_amdgcn_exp2f(S0[i]); S0[i + 1] = __builtin_amdgcn_exp2f(S0[i + 1]);
    S1[i] = __builtin_amdgcn_exp2f(S1[i]); S1[i + 1] = __builtin_amdgcn_exp2f(S1[i + 1]);
    f32x2 a2 = {S0[i], S0[i + 1]}, b2 = {S1[i], S1[i + 1]};
    rs2 += a2; rs2 += b2;
  }
  lrun += rs2[0] + rs2[1];
#pragma unroll
  for (int s = 0; s < 2; ++s) {
    bf16x8 pb = mk8(pk(S0[8 * s], S0[8 * s + 1]), pk(S0[8 * s + 2], S0[8 * s + 3]), pk(S0[8 * s + 4], S0[8 * s + 5]), pk(S0[8 * s + 6], S0[8 * s + 7]));
    const u16* a0 = cV + (16 * s + tr_row) * 72 + tr_col;
    s16x4 lo = tr16(a0), hi = tr16(a0 + 8 * 72);
    oa0 = MFMA32(__builtin_shufflevector(lo, hi, 0, 1, 2, 3, 4, 5, 6, 7), pb, oa0);
    lo = tr16(a0 + 32); hi = tr16(a0 + 8 * 72 + 32);
    oa1 = MFMA32(__builtin_shufflevector(lo, hi, 0, 1, 2, 3, 4, 5, 6, 7), pb, oa1);
  }
#pragma unroll
  for (int s = 0; s < 2; ++s) {
    bf16x8 pb = mk8(pk(S1[8 * s], S1[8 * s + 1]), pk(S1[8 * s + 2], S1[8 * s + 3]), pk(S1[8 * s + 4], S1[8 * s + 5]), pk(S1[8 * s + 6], S1[8 * s + 7]));
    const u16* a0 = cV + (16 * (2 + s) + tr_row) * 72 + tr_col;
    s16x4 lo = tr16(a0), hi = tr16(a0 + 8 * 72);
    oa0 = MFMA32(__builtin_shufflevector(lo, hi, 0, 1, 2, 3, 4, 5, 6, 7), pb, oa0);
    lo = tr16(a0 + 32); hi = tr16(a0 + 8 * 72 + 32);
    oa1 = MFMA32(__builtin_shufflevector(lo, hi, 0, 1, 2, 3, 4, 5, 6, 7), pb, oa1);
  }
}

DI void attn_item(const Params& p, int l, int item, unsigned char* smem) {
  int b, vh, qt;
  if (item < 1024) { qt = 2 + (item & 31); vh = (item >> 5) & 3; b = item >> 7; }
  else { int i2 = item - 1024; qt = i2 & 1; vh = (i2 >> 1) & 3; b = i2 >> 3; }
  const int nkeys = (qt < 2) ? 256 : T, t0 = qt * 128, ntiles = nkeys >> 6;
  u16* sK = (u16*)smem;
  u16* sV = sK + 2 * 64 * 72;
  const int tid = otid(), lane = tid & 63, w = tid >> 6, h = lane >> 5, r32 = lane & 31;
  const u16* Ub = (const u16*)(p.ws + WS_U) + (size_t)b * T * NIN;
  const int tq = t0 + 32 * w + r32;
  const u16* qp = Ub + (size_t)tq * NIN + 10 * 256 + vh * 64;
  const bf16x8 qf00 = *(const bf16x8*)(qp + 8 * h), qf01 = *(const bf16x8*)(qp + 16 + 8 * h);
  const bf16x8 qf10 = *(const bf16x8*)(qp + 32 + 8 * h), qf11 = *(const bf16x8*)(qp + 48 + 8 * h);
  f32x16 oacc00, oacc01, oacc10, oacc11;
#pragma unroll
  for (int i = 0; i < 16; ++i) { oacc00[i] = 0.f; oacc01[i] = 0.f; oacc10[i] = 0.f; oacc11[i] = 0.f; }
  float mrun0 = 0.f, mrun1 = 0.f, lrun0 = 0.f, lrun1 = 0.f;
  const int lk0 = tid >> 3, lcc = tid & 7;
  const u16* kbase = Ub + 11 * 256 + vh * 64 + lcc * 8;
  const u16* vbase = Ub + 12 * 256 + vh * 64 + lcc * 8;
  u32x4 ak0, ak1, av0, av1, bk0, bk1, bv0, bv1;
  const size_t ro0 = (size_t)lk0 * NIN, ro1 = (size_t)(lk0 + 32) * NIN;
  ak0 = *(const u32x4*)(kbase + ro0); ak1 = *(const u32x4*)(kbase + ro1);
  av0 = *(const u32x4*)(vbase + ro0); av1 = *(const u32x4*)(vbase + ro1);
  bk0 = *(const u32x4*)(kbase + ro0 + (size_t)64 * NIN); bk1 = *(const u32x4*)(kbase + ro1 + (size_t)64 * NIN);
  bv0 = *(const u32x4*)(vbase + ro0 + (size_t)64 * NIN); bv1 = *(const u32x4*)(vbase + ro1 + (size_t)64 * NIN);
  u16* wK0 = sK + lk0 * 72 + lcc * 8;
  u16* wV0 = sV + lk0 * 72 + lcc * 8;
  __syncthreads();
  *(u32x4*)(wK0) = ak0; *(u32x4*)(wK0 + 32 * 72) = ak1; *(u32x4*)(wV0) = av0; *(u32x4*)(wV0 + 32 * 72) = av1;
  __syncthreads();
  const int g = lane >> 4, i16 = lane & 15;
  const int tr_row = 4 * (g >> 1) + (i16 >> 2), tr_col = 16 * (g & 1) + 4 * (i16 & 3);
#pragma unroll 1
  for (int kt = 0; kt < ntiles; kt += 2) {
    if (kt + 2 < ntiles) {
      const size_t o = (size_t)(kt + 2) * 64 * NIN;
      ak0 = *(const u32x4*)(kbase + ro0 + o); ak1 = *(const u32x4*)(kbase + ro1 + o);
      av0 = *(const u32x4*)(vbase + ro0 + o); av1 = *(const u32x4*)(vbase + ro1 + o);
    }
    attn_sub(sK, sV, 0, h, r32, tr_row, tr_col, qf00, qf01, oacc00, oacc01, mrun0, lrun0, kt == 0);
    attn_sub(sK, sV, 32, h, r32, tr_row, tr_col, qf10, qf11, oacc10, oacc11, mrun1, lrun1, kt == 0);
    *(u32x4*)(wK0 + 64 * 72) = bk0; *(u32x4*)(wK0 + 96 * 72) = bk1; *(u32x4*)(wV0 + 64 * 72) = bv0; *(u32x4*)(wV0 + 96 * 72) = bv1;
    __syncthreads();
    if (kt + 3 < ntiles) {
      const size_t o = (size_t)(kt + 3) * 64 * NIN;
      bk0 = *(const u32x4*)(kbase + ro0 + o); bk1 = *(const u32x4*)(kbase + ro1 + o);
      bv0 = *(const u32x4*)(vbase + ro0 + o); bv1 = *(const u32x4*)(vbase + ro1 + o);
    }
    attn_sub(sK + 64 * 72, sV + 64 * 72, 0, h, r32, tr_row, tr_col, qf00, qf01, oacc00, oacc01, mrun0, lrun0, false);
    attn_sub(sK + 64 * 72, sV + 64 * 72, 32, h, r32, tr_row, tr_col, qf10, qf11, oacc10, oacc11, mrun1, lrun1, false);
    if (kt + 2 < ntiles) { *(u32x4*)(wK0) = ak0; *(u32x4*)(wK0 + 32 * 72) = ak1; *(u32x4*)(wV0) = av0; *(u32x4*)(wV0 + 32 * 72) = av1; }
    __syncthreads();
  }
  const float* lamp = (const float*)(p.ws + WS_LAM) + l * 2;
  const float lam = lamp[0], coef = lamp[1];
  float l0 = lrun0 + shx(lrun0, 32), l1 = lrun1 + shx(lrun1, 32);
  float i0 = 1.f / l0, i1 = lam / l1;
  float ss = 0.f;
#pragma unroll
  for (int i = 0; i < 16; ++i) {
    float o = oacc00[i] * i0 - oacc10[i] * i1; oacc00[i] = o; ss += o * o;
    o = oacc01[i] * i0 - oacc11[i] * i1; oacc01[i] = o; ss += o * o;
  }
  ss += shx(ss, 32);
  float rstd = rsqrtf(ss * (1.f / 64.f) + 1e-6f) * coef;
  const size_t row = (size_t)b * T + tq;
  const u16* gp = Ub + (size_t)tq * NIN + 13 * 256 + vh * 64;
  u16* yp = (u16*)(p.ws + WS_H) + row * 1024 + 768 + vh * 64;
  const float* ng = p.diff_norm_g + l * 64;
  uint2 gva[4], gvb[4];
  float4 nga[4], ngb[4];
#pragma unroll
  for (int g4 = 0; g4 < 4; ++g4) {
    gva[g4] = *(const uint2*)(gp + 8 * g4 + 4 * h); gvb[g4] = *(const uint2*)(gp + 32 + 8 * g4 + 4 * h);
    nga[g4] = *(const float4*)(ng + 8 * g4 + 4 * h); ngb[g4] = *(const float4*)(ng + 32 + 8 * g4 + 4 * h);
  }
#pragma unroll
  for (int g4 = 0; g4 < 4; ++g4) {
    {
      int dv = 8 * g4 + 4 * h;
      const uint2 gv = gva[g4];
      const float4 n4 = nga[g4];
      float y0 = oacc00[4 * g4] * rstd * n4.x * bflo(gv.x), y1 = oacc00[4 * g4 + 1] * rstd * n4.y * bfhi(gv.x);
      float y2 = oacc00[4 * g4 + 2] * rstd * n4.z * bflo(gv.y), y3 = oacc00[4 * g4 + 3] * rstd * n4.w * bfhi(gv.y);
      *(uint2*)(yp + dv) = make_uint2(pk(y0, y1), pk(y2, y3));
    }
    {
      int dv = 32 + 8 * g4 + 4 * h;
      const uint2 gv = gvb[g4];
      const float4 n4 = ngb[g4];
      float y0 = oacc01[4 * g4] * rstd * n4.x * bflo(gv.x), y1 = oacc01[4 * g4 + 1] * rstd * n4.y * bfhi(gv.x);
      float y2 = oacc01[4 * g4 + 2] * rstd * n4.z * bflo(gv.y), y3 = oacc01[4 * g4 + 3] * rstd * n4.w * bfhi(gv.y);
      *(uint2*)(yp + dv) = make_uint2(pk(y0, y1), pk(y2, y3));
    }
  }
}

template <bool OUT, int DIR>
DI void hgrn_dir(const Params& p, int b, int hh, int c, const u16* Ub, u16* sQ, u16* sKp, u16* sKd, u16* sV, float* sDec, f32x4 (&oacc)[4]) {
  const int tid = otid(), lane = tid & 63, w = tid >> 6, q = lane >> 4, r16 = lane & 15;
  __syncthreads();
  {
    const int d = tid & 63, I = tid >> 6;
    const int gcol = (4 + DIR) * 256 + hh * 64 + d, qcol = 2 * 256 + hh * 64 + d;
    float g[16], qv[16], gc[16];
#pragma unroll
    for (int tt = 0; tt < 16; ++tt) {
      const u16* rp = Ub + (size_t)(16 * I + tt) * NIN;
      g[tt] = bf2f(rp[gcol]); qv[tt] = bf2f(rp[qcol]);
    }
    float run = 0.f;
    if (DIR == 0) {
#pragma unroll
      for (int tt = 0; tt < 16; ++tt) { run += g[tt]; gc[tt] = run; }
    } else {
#pragma unroll
      for (int tt = 15; tt >= 0; --tt) { run += g[tt]; gc[tt] = run; }
    }
#pragma unroll
    for (int tt = 0; tt < 16; ++tt) {
      float kk = 1.f - __expf(g[tt]);
      int o = (16 * I + tt) * 80 + d;
      sQ[o] = f2bf(qv[tt] * __expf(gc[tt]));
      if (OUT) sKp[o] = f2bf(kk * __expf(fminf(-gc[tt], 80.f)));
      sKd[o] = f2bf(kk * __expf(run - gc[tt]));
    }
    sDec[I * 64 + d] = __expf(run);
#pragma unroll
    for (int i = 0; i < 2; ++i) {
      int ch = tid + 256 * i, row = ch >> 3, cc = ch & 7;
      *(uint4*)(sV + row * 80 + cc * 8) = *(const uint4*)(Ub + (size_t)row * NIN + 3 * 256 + hh * 64 + cc * 8);
    }
  }
  __syncthreads();
  const int chain = (b * 4 + hh) * 2 + DIR;
  if (!OUT && tid < 64)
    ((float*)(p.ws + WS_DB))[((size_t)chain * NCH + c) * 64 + tid] = sDec[tid] * sDec[64 + tid] * sDec[128 + tid] * sDec[192 + tid];
  float* Sg = (float*)(p.ws + WS_SB) + ((size_t)chain * NCH + c) * 4096;
  f32x4 S[4];
#pragma unroll
  for (int dt = 0; dt < 4; ++dt)
#pragma unroll
    for (int i = 0; i < 4; ++i) S[dt][i] = OUT ? Sg[(16 * dt + 4 * q + i) * 64 + 16 * w + r16] : 0.f;
#pragma unroll
  for (int step = 0; step < 4; ++step) {
    constexpr int dummy = 0; (void)dummy;
    const int I = DIR ? 3 - step : step;
    const int trr = (16 * I + 4 * q + (r16 >> 2)) * 80 + 4 * (r16 & 3);
    s16x4 vfrag = tr16(sV + trr + 16 * w);
    if (OUT) {
      const u16* kpp = sKp + (16 * I + r16) * 80 + 8 * q;
      const u16* qpp = sQ + (16 * I + r16) * 80;
      f32x4 sc = (f32x4){0.f, 0.f, 0.f, 0.f};
      sc = MFMA16(*(const bf16x8*)(kpp), *(const bf16x8*)(qpp + 8 * q), sc);
      sc = MFMA16(*(const bf16x8*)(kpp + 32), *(const bf16x8*)(qpp + 32 + 8 * q), sc);
#pragma unroll
      for (int i = 0; i < 4; ++i) {
        int j = 4 * q + i;
        bool keep = DIR ? (j >= r16) : (j <= r16);
        sc[i] = keep ? sc[i] : 0.f;
      }
      s16x4 pb = mk4(pk(sc[0], sc[1]), pk(sc[2], sc[3]));
      f32x4 oT = (f32x4){0.f, 0.f, 0.f, 0.f};
      oT = MFMA16K16(vfrag, pb, oT);
#pragma unroll
      for (int a = 0; a < 2; ++a) {
        bf16x8 sA = mk8(pk(S[2 * a][0], S[2 * a][1]), pk(S[2 * a][2], S[2 * a][3]), pk(S[2 * a + 1][0], S[2 * a + 1][1]), pk(S[2 * a + 1][2], S[2 * a + 1][3]));
        s16x4 lo = *(const s16x4*)(qpp + 32 * a + 4 * q), hi = *(const s16x4*)(qpp + 32 * a + 16 + 4 * q);
        bf16x8 bq = __builtin_shufflevector(lo, hi, 0, 1, 2, 3, 4, 5, 6, 7);
        oT = MFMA16(sA, bq, oT);
      }
      oacc[I] += oT;
    }
#pragma unroll
    for (int dt = 0; dt < 4; ++dt) {
      float4 d4 = *(const float4*)(sDec + I * 64 + 16 * dt + 4 * q);
      S[dt][0] *= d4.x; S[dt][1] *= d4.y; S[dt][2] *= d4.z; S[dt][3] *= d4.w;
      s16x4 kd = tr16(sKd + trr + 16 * dt);
      S[dt] = MFMA16K16(kd, vfrag, S[dt]);
    }
  }
  if (!OUT) {
#pragma unroll
    for (int dt = 0; dt < 4; ++dt)
#pragma unroll
      for (int i = 0; i < 4; ++i) Sg[(16 * dt + 4 * q + i) * 64 + 16 * w + r16] = S[dt][i];
  }
}

template <bool OUT>
DI void hgrn_item(const Params& p, int l, int item, unsigned char* smem) {
  const int c = item % NCH, hh = (item / NCH) & 3, b = item / (NCH * 4);
  u16* sQ = (u16*)smem;
  u16* sKp = sQ + 64 * 80;
  u16* sKd = sKp + 64 * 80;
  u16* sV = sKd + 64 * 80;
  float* sDec = (float*)(sV + 64 * 80);
  float* sRed = sDec + 256;
  const int tid = otid(), lane = tid & 63, w = tid >> 6, q = lane >> 4, r16 = lane & 15;
  const size_t rowbase = (size_t)b * T + c * 64;
  const u16* Ub = (const u16*)(p.ws + WS_U) + rowbase * NIN;
  f32x4 oacc[4];
#pragma unroll
  for (int i = 0; i < 4; ++i) oacc[i] = (f32x4){0.f, 0.f, 0.f, 0.f};
  hgrn_dir<OUT, 0>(p, b, hh, c, Ub, sQ, sKp, sKd, sV, sDec, oacc);
  hgrn_dir<OUT, 1>(p, b, hh, c, Ub, sQ, sKp, sKd, sV, sDec, oacc);
  if (OUT) {
    float part[4];
#pragma unroll
    for (int I = 0; I < 4; ++I) {
      part[I] = oacc[I][0] * oacc[I][0] + oacc[I][1] * oacc[I][1] + oacc[I][2] * oacc[I][2] + oacc[I][3] * oacc[I][3];
      part[I] += shx(part[I], 16);
      part[I] += shx(part[I], 32);
      if (q == 0) sRed[w * 64 + 16 * I + r16] = part[I];
    }
    __syncthreads();
    const float* ng = p.hgrn_norm_g + l * 64;
    const int e0 = 16 * w + 4 * q;
    float4 n4 = *(const float4*)(ng + e0);
    uint2 gvs[4];
#pragma unroll
    for (int I = 0; I < 4; ++I) gvs[I] = *(const uint2*)(Ub + (size_t)(16 * I + r16) * NIN + 6 * 256 + hh * 64 + e0);
#pragma unroll
    for (int I = 0; I < 4; ++I) {
      int t = 16 * I + r16;
      float tot = sRed[t] + sRed[64 + t] + sRed[128 + t] + sRed[192 + t];
      float rstd = rsqrtf(tot * (1.f / 64.f) + 1e-6f);
      const uint2 gv = gvs[I];
      float y0 = oacc[I][0] * rstd * n4.x * bflo(gv.x), y1 = oacc[I][1] * rstd * n4.y * bfhi(gv.x);
      float y2 = oacc[I][2] * rstd * n4.z * bflo(gv.y), y3 = oacc[I][3] * rstd * n4.w * bfhi(gv.y);
      *(uint2*)((u16*)(p.ws + WS_H) + (rowbase + t) * 1024 + 256 + hh * 64 + e0) = make_uint2(pk(y0, y1), pk(y2, y3));
    }
  }
}

DI void hgrn_scan_item(const Params& p, int item) {
  const int chain = item >> 3, slab = item & 7, dir = chain & 1;
  const int elem = slab * 512 + otid();
  float* Sb = (float*)(p.ws + WS_SB) + (size_t)chain * NCH * 4096 + elem;
  const float* Db = (const float*)(p.ws + WS_DB) + (size_t)chain * NCH * 64;
  const int d0 = elem >> 6, d1 = (elem + 256) >> 6;
  float run0 = 0.f, run1 = 0.f;
#pragma unroll 1
  for (int s0 = 0; s0 < NCH; s0 += 17) {
    float t0[17], t1[17], e0[17], e1[17];
#pragma unroll
    for (int j = 0; j < 17; ++j) {
      const int s = s0 + j;
      const int c = dir == 0 ? s : (s < 4 ? 3 - s : 71 - s);
      t0[j] = Sb[(size_t)c * 4096]; t1[j] = Sb[(size_t)c * 4096 + 256];
      e0[j] = Db[c * 64 + d0]; e1[j] = Db[c * 64 + d1];
    }
#pragma unroll
    for (int j = 0; j < 17; ++j) {
      const int s = s0 + j;
      const int c = dir == 0 ? s : (s < 4 ? 3 - s : 71 - s);
      Sb[(size_t)c * 4096] = run0; Sb[(size_t)c * 4096 + 256] = run1;
      run0 = e0[j] * run0 + t0[j]; run1 = e1[j] * run1 + t1[j];
    }
  }
}

template <bool FINAL, int DIR>
DI void lru_dir(const Params& p, int l, size_t rowb, int tb, int b, int c, const u16* sX, f32x2* sAU, float hcar, float (&hf)[64]) {
  const int tid = otid(), lane = tid & 63, w = tid >> 6, q = lane >> 4, r16 = lane & 15;
  const int ch = 64 * w + lane;
  const u16* U = (const u16*)(p.ws + WS_U);
  const u16* Wr = (const u16*)(p.ws + WS_WL) + (size_t)((((l * 2 + DIR) * 2 + 0) * 4 + w)) * 4096;
  const u16* Wi = (const u16*)(p.ws + WS_WL) + (size_t)((((l * 2 + DIR) * 2 + 1) * 4 + w)) * 4096;
  bf16x8 ar[4][2], ai[4][2];
#pragma unroll
  for (int jt = 0; jt < 4; ++jt)
#pragma unroll
    for (int ks = 0; ks < 2; ++ks) {
      ar[jt][ks] = *(const bf16x8*)(Wr + (16 * jt + r16) * 64 + 32 * ks + 8 * q);
      ai[jt][ks] = *(const bf16x8*)(Wi + (16 * jt + r16) * 64 + 32 * ks + 8 * q);
    }
  const float* brp = p.lru_b_r + (l * 2 + DIR) * 256 + 64 * w + 4 * q;
  const float* bip = p.lru_b_i + (l * 2 + DIR) * 256 + 64 * w + 4 * q;
  const float* lmp = p.lru_lambda + (l * 2 + DIR) * 256 + 64 * w + 4 * q;
  float spv[4][4];
#pragma unroll
  for (int jt = 0; jt < 4; ++jt) {
    float4 lm4 = *(const float4*)(lmp + 16 * jt);
    spv[jt][0] = log1pf(__expf(-lm4.x)); spv[jt][1] = log1pf(__expf(-lm4.y)); spv[jt][2] = log1pf(__expf(-lm4.z)); spv[jt][3] = log1pf(__expf(-lm4.w));
  }
  float h = hcar, aprod = 1.f;
#pragma unroll
  for (int s = 0; s < 4; ++s) {
    const int tt = DIR ? 3 - s : s;
    bf16x8 bx0 = *(const bf16x8*)(sX + (16 * tt + r16) * 272 + 64 * w + 8 * q);
    bf16x8 bx1 = *(const bf16x8*)(sX + (16 * tt + r16) * 272 + 64 * w + 32 + 8 * q);
#pragma unroll
    for (int jt = 0; jt < 4; ++jt) {
      f32x4 accr = (f32x4){0.f, 0.f, 0.f, 0.f}, acci = (f32x4){0.f, 0.f, 0.f, 0.f};
      accr = MFMA16(ar[jt][0], bx0, accr); accr = MFMA16(ar[jt][1], bx1, accr);
      acci = MFMA16(ai[jt][0], bx0, acci); acci = MFMA16(ai[jt][1], bx1, acci);
      float4 br4 = *(const float4*)(brp + 16 * jt), bi4 = *(const float4*)(bip + 16 * jt);
      float brv[4] = {br4.x, br4.y, br4.z, br4.w}, biv[4] = {bi4.x, bi4.y, bi4.z, bi4.w};
      uint2 xc2 = *(const uint2*)(sX + (16 * tt + r16) * 272 + 64 * w + 16 * jt + 4 * q);
      float xcv[4] = {bflo(xc2.x), bfhi(xc2.x), bflo(xc2.y), bfhi(xc2.y)};
#pragma unroll
      for (int i = 0; i < 4; ++i) {
        float r = sigm(accr[i] + brv[i]), ig = sigm(acci[i] + biv[i]);
        float la = -8.f * r * spv[jt][i];
        float a = __expf(la);
        float mult = __builtin_amdgcn_sqrtf(fmaxf((1.f - a) * (1.f + a), 0.f));
        f32x2 au = {a, mult * ig * xcv[i]};
        sAU[(w * 64 + 16 * jt + 4 * q + i) * 17 + r16] = au;
      }
    }
    __syncthreads();
    u16 gt[16];
    if (FINAL && DIR == 1) {
#pragma unroll
      for (int step = 0; step < 16; ++step) gt[step] = U[(rowb + tb + 16 * tt + (15 - step)) * NIN + 256 + ch];
    }
#pragma unroll
    for (int step = 0; step < 16; ++step) {
      const int tl = DIR ? 15 - step : step;
      f32x2 au = sAU[(w * 64 + lane) * 17 + tl];
      h = au.x * h + au.y;
      if (FINAL) {
        if (DIR == 0) hf[16 * tt + tl] = h;
        else {
          const int t = 16 * tt + tl;
          float y = hf[t] + h;
          ((u16*)(p.ws + WS_H))[(rowb + tb + t) * 1024 + ch] = f2bf(y * bf2f(gt[step]));
        }
      } else aprod *= au.x;
    }
    __syncthreads();
  }
  if (!FINAL) {
    f32x2 o = {aprod, h};
    ((f32x2*)(p.ws + WS_LS))[((size_t)(b * 2 + DIR) * NCH + c) * 256 + ch] = o;
  }
}

DI float lru_chain(const f32x2* L, int start, int step, int n, float hh) {
  for (int k0 = 0; k0 < n; k0 += 16) {
    f32x2 v[16];
#pragma unroll
    for (int j = 0; j < 16; ++j) {
      const int k = k0 + j;
      v[j] = (f32x2){1.f, 0.f};
      if (k < n) v[j] = L[(size_t)(start + k * step) * 256];
    }
#pragma unroll
    for (int j = 0; j < 16; ++j) hh = v[j].x * hh + v[j].y;
  }
  return hh;
}

template <bool FINAL>
DI void lru_item(const Params& p, int l, int item, unsigned char* smem) {
  const int b = item / NCH, c = item % NCH;
  const int seg_lo = c < 4 ? 0 : LCTX, seg_hi = c < 4 ? LCTX : T, tb = c * 64;
  u16* sX = (u16*)smem;
  f32x2* sAU = (f32x2*)(smem + 64 * 272 * 2);
  const int tid = otid(), lane = tid & 63, w = tid >> 6;
  const u16* U = (const u16*)(p.ws + WS_U);
  const size_t rowb = (size_t)b * T;
  __syncthreads();
  {
    const int c4 = (tid & 63) * 4, tg = tid >> 6;
    float4 wk[4];
#pragma unroll
    for (int k = 0; k < 4; ++k) wk[k] = *(const float4*)(p.lru_conv_w + (l * 4 + k) * 256 + c4);
    float4 bias = *(const float4*)(p.lru_conv_b + l * 256 + c4);
    uint2 xr[19];
#pragma unroll
    for (int n = 0; n < 19; ++n) {
      int ts = tb + tg * 16 - 2 + n;
      xr[n] = make_uint2(0u, 0u);
      if (ts >= seg_lo && ts < seg_hi) xr[n] = *(const uint2*)(U + (rowb + ts) * NIN + c4);
    }
#pragma unroll
    for (int tt = 0; tt < 16; ++tt) {
      float o0 = bias.x, o1 = bias.y, o2 = bias.z, o3 = bias.w;
#pragma unroll
      for (int k = 0; k < 4; ++k) {
        o0 += wk[k].x * bflo(xr[tt + k].x); o1 += wk[k].y * bfhi(xr[tt + k].x); o2 += wk[k].z * bflo(xr[tt + k].y); o3 += wk[k].w * bfhi(xr[tt + k].y);
      }
      *(uint2*)(sX + (tg * 16 + tt) * 272 + c4) = make_uint2(pk(o0, o1), pk(o2, o3));
    }
  }
  __syncthreads();
  const int ch = 64 * w + lane;
  const f32x2* LSr = (const f32x2*)(p.ws + WS_LS);
  float hcar0 = 0.f, hcar1 = 0.f;
  if (FINAL) {
    const f32x2* L0 = LSr + ((size_t)(b * 2 + 0) * NCH) * 256 + ch;
    hcar0 = lru_chain(L0, 0, 1, c, 0.f);
    const f32x2* L1 = LSr + ((size_t)(b * 2 + 1) * NCH) * 256 + ch;
    float hh = 0.f;
    if (c < 4) hh = lru_chain(L1, 3, -1, 3 - c, 0.f);
    else { hh = lru_chain(L1, 3, -1, 4, 0.f); hh = lru_chain(L1, NCH - 1, -1, NCH - 1 - c, hh); }
    hcar1 = hh;
  }
  float hf[64];
  lru_dir<FINAL, 0>(p, l, rowb, tb, b, c, sX, sAU, hcar0, hf);
  lru_dir<FINAL, 1>(p, l, rowb, tb, b, c, sX, sAU, hcar1, hf);
}

DI void conf_item(const Params& p, int l, int item, unsigned char* smem) {
  const int b = item / NCH, c = item % NCH;
  const int seg_lo = c < 4 ? 0 : LCTX, seg_hi = c < 4 ? LCTX : T, tb = c * 64;
  float* sC = (float*)smem;
  const int tid = otid(), lane = tid & 63, w = tid >> 6, ch = tid;
  const u16* U = (const u16*)(p.ws + WS_U);
  const size_t rowb = (size_t)b * T;
  float wk[31], win[31];
#pragma unroll
  for (int k = 0; k < 31; ++k) { wk[k] = p.conf_conv_w[(l * 31 + k) * 256 + ch]; win[k] = 0.f; }
  const float bias = p.conf_conv_b[l * 256 + ch];
  __syncthreads();
  for (int base = 0; base < 94; base += 31) {
#pragma unroll
    for (int i = 0; i < 31; ++i) {
      const int n = base + i;
      if (n < 94) {
        const int ts = tb - 15 + n;
        float y = 0.f;
        if (ts >= seg_lo && ts < seg_hi) {
          const u16* rp = U + (rowb + ts) * NIN;
          y = bf2f(rp[7 * 256 + ch]) * bf2f(rp[8 * 256 + ch]);
        }
        win[i] = y;
        if (n >= 30) {
          float acc = bias;
#pragma unroll
          for (int k = 0; k < 31; ++k) acc += wk[k] * win[(i + 1 + k) % 31];
          sC[(n - 30) * 256 + ch] = acc;
        }
      }
    }
  }
  __syncthreads();
  float4 g4 = *(const float4*)(p.conf_ln_g + l * 256 + 4 * lane), b4 = *(const float4*)(p.conf_ln_b + l * 256 + 4 * lane);
  uint2 gts[16];
#pragma unroll
  for (int rr = 0; rr < 16; ++rr) gts[rr] = *(const uint2*)(U + (rowb + tb + w * 16 + rr) * NIN + 9 * 256 + 4 * lane);
#pragma unroll
  for (int rr = 0; rr < 16; ++rr) {
    const int t = w * 16 + rr;
    float4 v = *(const float4*)(sC + t * 256 + 4 * lane);
    float s = wave_sum(v.x + v.y + v.z + v.w);
    float mu = s * (1.f / 256.f);
    float d0 = v.x - mu, d1 = v.y - mu, d2 = v.z - mu, d3 = v.w - mu;
    float var = wave_sum(d0 * d0 + d1 * d1 + d2 * d2 + d3 * d3) * (1.f / 256.f);
    float rstd = rsqrtf(var + 1e-5f);
    const uint2 gv = gts[rr];
    float y0 = silu(d0 * rstd * g4.x + b4.x) * bflo(gv.x), y1 = silu(d1 * rstd * g4.y + b4.y) * bfhi(gv.x);
    float y2 = silu(d2 * rstd * g4.z + b4.z) * bflo(gv.y), y3 = silu(d3 * rstd * g4.w + b4.w) * bfhi(gv.y);
    *(uint2*)((u16*)(p.ws + WS_H) + (rowb + tb + t) * 1024 + 512 + 4 * lane) = make_uint2(pk(y0, y1), pk(y2, y3));
  }
}


__global__ void __launch_bounds__(256, 2) fwd_megakernel(Params p) {
  extern __shared__ __attribute__((aligned(16))) unsigned char smem[];
  __shared__ int s_item;
  __shared__ uint4 xb_words;
  cg::grid_group grid = cg::this_grid();
  unsigned* ctr = (unsigned*)(p.ws + WS_CTL);
  const int tid = otid();
  if (tid == 0) xb_words = make_uint4(0u, 0u, 0u, 0u);
  __syncthreads();
  (void)xcd_barrier_post((unsigned*)(p.ws + WS_CTL + 4096), (volatile LAS unsigned*)&xb_words);
  grid.sync();

  phase_prologue(p, smem);
  xcd_barrier((unsigned*)(p.ws + WS_CTL + 4096), (volatile LAS unsigned*)&xb_words);
  for (int l = 0; l < DEPTH; ++l) {
    phase_norm(p, l);
    xcd_barrier((unsigned*)(p.ws + WS_CTL + 4096), (volatile LAS unsigned*)&xb_words);
    phase_gemm<0>(p, l, smem);
    xcd_barrier((unsigned*)(p.ws + WS_CTL + 4096), (volatile LAS unsigned*)&xb_words);
    {
      constexpr int N_ATT = 1088, N_HG = 2176, N_LRU = 544, N_CONF = 544, TOTAL = N_ATT + N_HG + N_LRU + N_CONF;
      for (;;) {
        __syncthreads();
        if (tid == 0) s_item = (int)atomicAdd(&ctr[l * 2], 1u);
        __syncthreads();
        int it = s_item;
        if (it >= TOTAL) break;
        if (it < N_ATT) attn_item(p, l, it, smem);
        else if (it < N_ATT + N_LRU) lru_item<false>(p, l, it - N_ATT, smem);
        else if (it < N_ATT + N_LRU + N_CONF) conf_item(p, l, it - N_ATT - N_LRU, smem);
        else hgrn_item<false>(p, l, it - N_ATT - N_LRU - N_CONF, smem);
      }
    }
    xcd_barrier((unsigned*)(p.ws + WS_CTL + 4096), (volatile LAS unsigned*)&xb_words);
    for (int it = blockIdx.x; it < 512; it += gridDim.x) hgrn_scan_item(p, it);
    xcd_barrier((unsigned*)(p.ws + WS_CTL + 4096), (volatile LAS unsigned*)&xb_words);
    {
      constexpr int N_LRU = 544, TOTAL = N_LRU + 2176;
      for (;;) {
        __syncthreads();
        if (tid == 0) s_item = (int)atomicAdd(&ctr[l * 2 + 1], 1u);
        __syncthreads();
        int it = s_item;
        if (it >= TOTAL) break;
        if (it < N_LRU) lru_item<true>(p, l, it, smem);
        else hgrn_item<true>(p, l, it - N_LRU, smem);
      }
    }
    xcd_barrier((unsigned*)(p.ws + WS_CTL + 4096), (volatile LAS unsigned*)&xb_words);
    phase_gemm<1>(p, l, smem);
    xcd_barrier((unsigned*)(p.ws + WS_CTL + 4096), (volatile LAS unsigned*)&xb_words);
  }
  phase_norm(p, DEPTH);
}

extern "C" void kernel_launch(void* const* d_in, const int* in_sizes, int n_in, void* d_out, int out_size, void* d_ws, size_t ws_size,
                              hipStream_t stream) {
  static int grid_blocks = 0;
  if (grid_blocks == 0) {
    int dev = 0, cus = 0, per_cu = 0;
    hipGetDevice(&dev);
    hipDeviceGetAttribute(&cus, hipDeviceAttributeMultiprocessorCount, dev);
    if (hipFuncSetAttribute((const void*)fwd_megakernel, hipFuncAttributeMaxDynamicSharedMemorySize, LDS_BYTES) != hipSuccess) {
      fprintf(stderr, "kernel_launch: hipFuncSetAttribute failed\n");
    }
    hipOccupancyMaxActiveBlocksPerMultiprocessor(&per_cu, (const void*)fwd_megakernel, 256, LDS_BYTES);
    if (per_cu > 2) per_cu = 2;
    if (per_cu < 1) { fprintf(stderr, "kernel_launch: occupancy query returned %d\n", per_cu); per_cu = 1; }
    grid_blocks = cus * per_cu;
    if (ws_size < WS_END) fprintf(stderr, "kernel_launch: workspace too small: %zu < %zu\n", ws_size, (size_t)WS_END);
  }
  Params p{};
  const float** pp = (const float**)&p;
  for (int i = 0; i < 28; ++i) pp[i] = (const float*)d_in[i];
  p.out = (float*)d_out;
  p.ws = (unsigned char*)d_ws;
  hipMemsetAsync((char*)d_ws + WS_CTL, 0, 65536, stream);
  void* args[] = {&p};
  hipError_t e = hipLaunchCooperativeKernel((const void*)fwd_megakernel, dim3(grid_blocks), dim3(256), args, LDS_BYTES, stream);
  if (e != hipSuccess) fprintf(stderr, "cooperative launch failed: %s (grid %d)\n", hipGetErrorString(e), grid_blocks);
}
```

```cpp
#include <hip/hip_runtime.h>
#include <hip/hip_cooperative_groups.h>
#include <cstdio>
namespace cg = cooperative_groups;

#define DI __device__ __forceinline__
typedef short bf16x8 __attribute__((ext_vector_type(8)));
typedef short s16x4 __attribute__((ext_vector_type(4)));
typedef float f32x4 __attribute__((ext_vector_type(4)));
typedef float f32x16 __attribute__((ext_vector_type(16)));
typedef float f32x2 __attribute__((ext_vector_type(2)));
typedef __bf16 bf16_2 __attribute__((ext_vector_type(2)));
typedef unsigned short u16;
typedef unsigned int u32;
typedef u32 u32x4 __attribute__((ext_vector_type(4)));
typedef u32 u32x2 __attribute__((ext_vector_type(2)));

constexpr int NB = 8, LCTX = 256, T = 4352, M = NB * T, D = 1024, NIN = 3584, DEPTH = 4, NCH = 68;
constexpr float QSCALE = 0.17677669529663687f * 1.4426950408889634f;

constexpr size_t WS_CTL = 0;
constexpr size_t WS_MOD = 65536;
constexpr size_t WS_COS = WS_MOD + 524288;
constexpr size_t WS_SIN = WS_COS + 262144;
constexpr size_t WS_LB = WS_SIN + 262144;
constexpr size_t WS_LAM = WS_LB + 8192;
constexpr size_t WS_WIN = WS_LAM + 8192;
constexpr size_t WS_WOUT = WS_WIN + (size_t)4 * 3584 * 1024 * 2;
constexpr size_t WS_WL = WS_WOUT + (size_t)4 * 1024 * 1024 * 2;
constexpr size_t WS_XC = WS_WL + 524288;
constexpr size_t WS_H = WS_XC + (size_t)8 * 256 * 1024 * 4;
constexpr size_t WS_U = WS_H + (size_t)M * 1024 * 2;
constexpr size_t WS_SB = WS_U + (size_t)M * 3584 * 2;
constexpr size_t WS_DB = WS_SB + (size_t)64 * 68 * 4096 * 4;
constexpr size_t WS_LS = WS_DB + (size_t)64 * 68 * 64 * 4;
constexpr size_t WS_END = WS_LS + (size_t)8 * 2 * 68 * 256 * 8;

constexpr int LDS_BYTES = 73728;

struct Params {
  const float *x, *c, *ctx, *c_ctx, *w_mod, *b_mod, *g_pre, *g_post, *w_in, *w_out,
      *lru_conv_w, *lru_conv_b, *lru_w_r, *lru_b_r, *lru_w_i, *lru_b_i, *lru_lambda,
      *hgrn_lb, *hgrn_norm_g, *conf_conv_w, *conf_conv_b, *conf_ln_g, *conf_ln_b,
      *lam_q1, *lam_k1, *lam_q2, *lam_k2, *diff_norm_g;
  float* out;
  unsigned char* ws;
};

DI u32 pk(float lo, float hi) { f32x2 v = {lo, hi}; bf16_2 r = __builtin_convertvector(v, bf16_2); return __builtin_bit_cast(u32, r); }
DI u16 f2bf(float x) { return (u16)(pk(x, 0.f) & 0xffffu); }
DI float bf2f(u16 h) { return __uint_as_float(((u32)h) << 16); }
DI float bflo(u32 v) { return __uint_as_float(v << 16); }
DI float bfhi(u32 v) { return __uint_as_float(v & 0xffff0000u); }
DI bf16x8 mk8(u32 a, u32 b, u32 c, u32 d) { u32x4 v = {a, b, c, d}; return __builtin_bit_cast(bf16x8, v); }
DI s16x4 mk4(u32 a, u32 b) { u32x2 v = {a, b}; return __builtin_bit_cast(s16x4, v); }
DI float sigm(float x) { return __builtin_amdgcn_rcpf(1.f + __expf(-x)); }
DI float silu(float x) { return x * __builtin_amdgcn_rcpf(1.f + __expf(-x)); }
DI int otid() { int t = threadIdx.x; asm volatile("" : "+v"(t)); return t; }
DI float shx(float v, int o) { int ln = otid() & 63; return __int_as_float(__builtin_amdgcn_ds_bpermute((ln ^ o) << 2, __float_as_int(v))); }
DI float wave_sum(float v) {
#pragma unroll
  for (int o = 32; o > 0; o >>= 1) v += shx(v, o);
  return v;
}
DI s16x4 tr16(const u16* p) {
  return __builtin_amdgcn_ds_read_tr16_b64_v4i16((__attribute__((address_space(3))) s16x4*)p);
}
#define MFMA16(a, b, c) __builtin_amdgcn_mfma_f32_16x16x32_bf16((a), (b), (c), 0, 0, 0)
DI f32x4 mfma16k16_pad(s16x4 a, s16x4 b, f32x4 c) {
  const s16x4 z = {0, 0, 0, 0};
  return __builtin_amdgcn_mfma_f32_16x16x32_bf16(__builtin_shufflevector(a, z, 0, 1, 2, 3, 4, 5, 6, 7), __builtin_shufflevector(b, z, 0, 1, 2, 3, 4, 5, 6, 7), c, 0, 0, 0);
}
#define MFMA16K16(a, b, c) mfma16k16_pad((a), (b), (c))
#define MFMA32(a, b, c) __builtin_amdgcn_mfma_f32_32x32x16_bf16((a), (b), (c), 0, 0, 0)


#define XB_TMO      128
#define XB_XCNT(j)  (256  + 64 * (j))
#define XB_XSUB(j)  (1280 + 64 * (j))
#define XB_XGEN(j)  (2304 + 64 * (j))
#define XB_TOP      3328
#define XB_TOPGEN   3392
#define XCD_BAR_WORDS 3456
#define XB_SPIN_CAP (1u << 22)
#define LAS __attribute__((address_space(3)))
DI unsigned xb_ld(unsigned* p) { return __hip_atomic_load(p, __ATOMIC_RELAXED, __HIP_MEMORY_SCOPE_AGENT); }
DI unsigned xb_add(unsigned* p, unsigned v) { return __hip_atomic_fetch_add(p, v, __ATOMIC_RELAXED, __HIP_MEMORY_SCOPE_AGENT); }
DI unsigned xb_xcc_id() { return (unsigned)__builtin_amdgcn_s_getreg((3 << 11) | 20) & 0xFu; }
#define XB_SPIN(cond, bar) do { unsigned _sp = 0; while (cond) { __builtin_amdgcn_s_sleep(1); \
    if ((++_sp & 255u) == 0u) { if (xb_ld(&(bar)[XB_TMO])) break; if (_sp > XB_SPIN_CAP) { atomicAdd(&(bar)[XB_TMO], 1u); break; } } } } while (0)
struct XcdBarrier { unsigned* bar; unsigned x; volatile LAS unsigned* st; };
DI XcdBarrier xcd_barrier_post(unsigned* bar, volatile LAS unsigned* st) {
  XcdBarrier b; b.bar = bar; b.x = xb_xcc_id(); b.st = st;
  if (threadIdx.x == 0) (void)xb_add(&bar[XB_XCNT(b.x)], 1u);
  return b;
}
DI void xcd_barrier_complete(unsigned* bar, unsigned x, unsigned& nloc, unsigned& nx) {
  const unsigned G = gridDim.x * gridDim.y * gridDim.z;
  unsigned sum, cnt, mine, sp = 0u;
  for (;;) {
    sum = 0u; cnt = 0u; mine = 0u;
#pragma unroll
    for (unsigned j = 0; j < 16; ++j) { const unsigned c = xb_ld(&bar[XB_XCNT(j)]); sum += c; cnt += (c > 0u) ? 1u : 0u; mine = (j == x) ? c : mine; }
    if (sum == G) break;
    __builtin_amdgcn_s_sleep(1);
    if ((++sp & 255u) == 0u) { if (xb_ld(&bar[XB_TMO])) break; if (sp > XB_SPIN_CAP) { atomicAdd(&bar[XB_TMO], 1u); break; } }
  }
  nloc = mine > 0u ? mine : 1u; nx = cnt > 0u ? cnt : 1u;
}
DI void xcd_barrier(unsigned* bar_in, volatile LAS unsigned* st_in) {
  XcdBarrier b; b.bar = bar_in; b.x = xb_xcc_id(); b.st = st_in;
  asm volatile("s_waitcnt vmcnt(0)" ::: "memory");
  __syncthreads();
  if (threadIdx.x == 0) {
    unsigned* bar = b.bar;
    __builtin_amdgcn_s_waitcnt(0);
    unsigned nloc = b.st[0], nx = b.st[1];
    if (nloc == 0u) { xcd_barrier_complete(bar, b.x, nloc, nx); b.st[0] = nloc; b.st[1] = nx; }
    const unsigned old = xb_add(&bar[XB_XSUB(b.x)], 1u);
    const unsigned gen = old / nloc;
    if (old + 1u == (gen + 1u) * nloc) {
      __builtin_amdgcn_fence(__ATOMIC_RELEASE, "agent");
      asm volatile("s_waitcnt vmcnt(0)" ::: "memory");
      const unsigned og = xb_add(&bar[XB_TOP], 1u);
      const unsigned tg = og / nx;
      if (og + 1u == (tg + 1u) * nx) xb_add(&bar[XB_TOPGEN], 1u);
      else XB_SPIN(xb_ld(&bar[XB_TOPGEN]) == tg, bar);
      __builtin_amdgcn_fence(__ATOMIC_ACQUIRE, "agent");
      xb_add(&bar[XB_XGEN(b.x)], 1u);
      asm volatile("s_waitcnt vmcnt(0)" ::: "memory");
    } else {
      XB_SPIN(xb_ld(&bar[XB_XGEN(b.x)]) == gen, bar);
      __builtin_amdgcn_fence(__ATOMIC_ACQUIRE, "agent");
      asm volatile("s_waitcnt vmcnt(0)" ::: "memory");
    }
  }
  __syncthreads();
}

DI void transpose_cvt(const float* src, int ld_src, u16* dst, int ld_dst, float* tile) {
  const int tid = otid();
#pragma unroll
  for (int i = 0; i < 4; ++i) {
    int r = (tid >> 4) + 16 * i, c4 = (tid & 15) * 4;
    float4 v = *(const float4*)(src + (size_t)r * ld_src + c4);
    tile[r * 65 + c4] = v.x; tile[r * 65 + c4 + 1] = v.y; tile[r * 65 + c4 + 2] = v.z; tile[r * 65 + c4 + 3] = v.w;
  }
  __syncthreads();
  int n = tid >> 2, kq = (tid & 3) * 16;
  u32 pkv[8];
#pragma unroll
  for (int j = 0; j < 8; ++j) pkv[j] = pk(tile[(kq + 2 * j) * 65 + n], tile[(kq + 2 * j + 1) * 65 + n]);
  uint4* d = (uint4*)(dst + (size_t)n * ld_dst + kq);
  d[0] = make_uint4(pkv[0], pkv[1], pkv[2], pkv[3]);
  d[1] = make_uint4(pkv[4], pkv[5], pkv[6], pkv[7]);
  __syncthreads();
}

DI void phase_prologue(const Params& p, unsigned char* smem) {
  const int tid = otid();
  constexpr int N_WIN = 4 * 16 * 56, N_WOUT = 4 * 16 * 16, N_WL = 64, N_MOD = 4 * 96, N_ROPE = 256, N_LB = 1;
  constexpr int TOTAL = N_WIN + N_WOUT + N_WL + N_MOD + N_ROPE + N_LB;
  float* fs = (float*)smem;
  for (int it = blockIdx.x; it < TOTAL; it += gridDim.x) {
    int i = it;
    if (i < N_WIN) {
      int l = i / (16 * 56), r = i % (16 * 56), kt = r / 56, nt = r % 56;
      transpose_cvt(p.w_in + (size_t)l * 1024 * NIN + (size_t)kt * 64 * NIN + nt * 64, NIN,
                    (u16*)(p.ws + WS_WIN) + (size_t)l * NIN * 1024 + (size_t)nt * 64 * 1024 + kt * 64, 1024, fs);
      continue;
    }
    i -= N_WIN;
    if (i < N_WOUT) {
      int l = i / 256, r = i % 256, kt = r / 16, nt = r % 16;
      transpose_cvt(p.w_out + (size_t)l * 1024 * 1024 + (size_t)kt * 64 * 1024 + nt * 64, 1024,
                    (u16*)(p.ws + WS_WOUT) + (size_t)l * 1024 * 1024 + (size_t)nt * 64 * 1024 + kt * 64, 1024, fs);
      continue;
    }
    i -= N_WOUT;
    if (i < N_WL) {
      int head = i & 3, which = (i >> 2) & 1, ld = i >> 3;
      const float* src = (which ? p.lru_w_i : p.lru_w_r) + ((size_t)ld * 4 + head) * 4096;
      transpose_cvt(src, 64, (u16*)(p.ws + WS_WL) + (size_t)i * 4096, 64, fs);
      continue;
    }
    i -= N_WL;
    if (i < N_MOD) {
      int l = i / 96, cg = i % 96;
      float* sv = fs;
      float* red = fs + 9216;
      __syncthreads();
      for (int idx = tid; idx < 9216; idx += 256) {
        int m = idx >> 10, k = idx & 1023;
        float v = (m < 8) ? p.c[m * 1024 + k] : p.c_ctx[k];
        sv[idx] = silu(v);
      }
      __syncthreads();
      int cl = tid & 31, kg = tid >> 5, col = cg * 32 + cl;
      float acc[9];
#pragma unroll
      for (int m = 0; m < 9; ++m) acc[m] = 0.f;
      const float* wp = p.w_mod + (size_t)l * 1024 * 3072 + col;
#pragma unroll 4
      for (int k = kg * 128; k < kg * 128 + 128; ++k) {
        float w = wp[(size_t)k * 3072];
#pragma unroll
        for (int m = 0; m < 9; ++m) acc[m] += sv[m * 1024 + k] * w;
      }
#pragma unroll
      for (int m = 0; m < 9; ++m) red[(kg * 9 + m) * 32 + cl] = acc[m];
      __syncthreads();
      for (int o = tid; o < 288; o += 256) {
        int m = o >> 5, c2 = o & 31, col2 = cg * 32 + c2;
        float s = p.b_mod[l * 3072 + col2];
#pragma unroll
        for (int g = 0; g < 8; ++g) s += red[(g * 9 + m) * 32 + c2];
        ((float*)(p.ws + WS_MOD))[(l * 9 + m) * 3072 + col2] = s;
      }
      __syncthreads();
      continue;
    }
    i -= N_MOD;
    if (i < N_ROPE) {
      int idx = i * 256 + tid, pos = idx >> 4, j = idx & 15, f = j & 7;
      float inv = powf(10000.f, -(float)f / 8.f);
      float pp = (j < 8) ? (float)(pos >> 6) : (float)(pos & 63);
      float ang = pp * inv;
      ((float*)(p.ws + WS_COS))[idx] = cosf(ang);
      ((float*)(p.ws + WS_SIN))[idx] = sinf(ang);
      continue;
    }
    i -= N_ROPE;
    {
      float* lbo = (float*)(p.ws + WS_LB);
      for (int idx = tid; idx < 512; idx += 256) {
        float v[4], mx = -1e30f;
#pragma unroll
        for (int l = 0; l < 4; ++l) { v[l] = p.hgrn_lb[l * 512 + idx]; mx = fmaxf(mx, v[l]); }
        float s = 0.f;
#pragma unroll
        for (int l = 0; l < 4; ++l) { v[l] = expf(v[l] - mx); s += v[l]; }
        float cum = 0.f;
        lbo[idx] = 0.f;
#pragma unroll
        for (int l = 1; l < 4; ++l) { cum += v[l] / s; lbo[l * 512 + idx] = cum; }
      }
      if (tid < 4) {
        int l = tid;
        float s1 = 0.f, s2 = 0.f;
        for (int k = 0; k < 32; ++k) { s1 += p.lam_q1[l * 32 + k] * p.lam_k1[l * 32 + k]; s2 += p.lam_q2[l * 32 + k] * p.lam_k2[l * 32 + k]; }
        float li = 0.8f - 0.6f * expf(-0.3f * (float)l);
        float* lo = (float*)(p.ws + WS_LAM);
        lo[l * 2] = expf(s1) - expf(s2) + li;
        lo[l * 2 + 1] = 1.f - li;
      }
    }
  }
}

DI void phase_norm(const Params& p, int l) {
  const int tid = otid(); const int lane = tid & 63, gw = blockIdx.x * 4 + (tid >> 6), nw = gridDim.x * 4;
  const float* modp = (const float*)(p.ws + WS_MOD);
  const u16* Obuf = (const u16*)(p.ws + WS_U);
  u16* H = (u16*)(p.ws + WS_H);
  float* XC = (float*)(p.ws + WS_XC);
  for (int row = gw; row < M; row += nw) {
    int b = row / T, t = row - b * T;
    bool isctx = t < LCTX;
    int bm = isctx ? 8 : b;
    if (l == DEPTH && isctx) continue;
    float* xout;
    const float* xin;
    if (isctx) { xout = XC + ((size_t)b * 256 + t) * 1024; xin = (l <= 1) ? p.ctx + ((size_t)b * 256 + t) * 1024 : xout; }
    else { xout = p.out + ((size_t)b * 4096 + (t - 256)) * 1024; xin = (l <= 1) ? p.x + ((size_t)b * 4096 + (t - 256)) * 1024 : xout; }
    float4 xv[4];
#pragma unroll
    for (int j = 0; j < 4; ++j) xv[j] = *(const float4*)(xin + lane * 4 + 256 * j);
    if (l > 0) {
      const u16* O = Obuf + (size_t)row * 1024;
      float4 ov[4];
      float ss = 0.f;
#pragma unroll
      for (int j = 0; j < 4; ++j) {
        uint2 o2 = *(const uint2*)(O + lane * 4 + 256 * j);
        ov[j] = make_float4(bflo(o2.x), bfhi(o2.x), bflo(o2.y), bfhi(o2.y));
        ss += ov[j].x * ov[j].x + ov[j].y * ov[j].y + ov[j].z * ov[j].z + ov[j].w * ov[j].w;
      }
      ss = wave_sum(ss);
      float rs = rsqrtf(ss * (1.f / 1024.f) + 1e-6f);
      const float* gate = modp + ((l - 1) * 9 + bm) * 3072 + 2048;
      const float* gp = p.g_post + (l - 1) * 1024;
      float4 g4s[4], w4s[4];
#pragma unroll
      for (int j = 0; j < 4; ++j) { g4s[j] = *(const float4*)(gate + lane * 4 + 256 * j); w4s[j] = *(const float4*)(gp + lane * 4 + 256 * j); }
#pragma unroll
      for (int j = 0; j < 4; ++j) {
        int col = lane * 4 + 256 * j;
        const float4 g4 = g4s[j], w4 = w4s[j];
        xv[j].x += g4.x * (ov[j].x * rs * w4.x); xv[j].y += g4.y * (ov[j].y * rs * w4.y);
        xv[j].z += g4.z * (ov[j].z * rs * w4.z); xv[j].w += g4.w * (ov[j].w * rs * w4.w);
        *(float4*)(xout + col) = xv[j];
      }
    }
    if (l < DEPTH) {
      float ss = 0.f;
#pragma unroll
      for (int j = 0; j < 4; ++j) ss += xv[j].x * xv[j].x + xv[j].y * xv[j].y + xv[j].z * xv[j].z + xv[j].w * xv[j].w;
      ss = wave_sum(ss);
      float rs = rsqrtf(ss * (1.f / 1024.f) + 1e-6f);
      const float* shift = modp + (l * 9 + bm) * 3072;
      const float* scale = shift + 1024;
      const float* gpre = p.g_pre + l * 1024;
      float4 s4s[4], c4s[4], q4s[4];
#pragma unroll
      for (int j = 0; j < 4; ++j) { int col = lane * 4 + 256 * j; s4s[j] = *(const float4*)(shift + col); c4s[j] = *(const float4*)(scale + col); q4s[j] = *(const float4*)(gpre + col); }
#pragma unroll
      for (int j = 0; j < 4; ++j) {
        int col = lane * 4 + 256 * j;
        const float4 s4 = s4s[j], c4 = c4s[j], g4 = q4s[j];
        float h0 = xv[j].x * rs * g4.x * (1.f + c4.x) + s4.x, h1 = xv[j].y * rs * g4.y * (1.f + c4.y) + s4.y;
        float h2 = xv[j].z * rs * g4.z * (1.f + c4.z) + s4.z, h3 = xv[j].w * rs * g4.w * (1.f + c4.w) + s4.w;
        *(uint2*)(H + (size_t)row * 1024 + col) = make_uint2(pk(h0, h1), pk(h2, h3));
      }
    }
  }
}

DI void g_load(u32x4 (&rw)[4], u32x4 (&rx)[4], const u16* Wb, const u16* Xb, unsigned off) {
#pragma unroll
  for (int i = 0; i < 4; ++i) {
    rw[i] = *(const u32x4*)(Wb + (off + (unsigned)i * 32u * 1024u));
    rx[i] = *(const u32x4*)(Xb + (off + (unsigned)i * 32u * 1024u));
  }
}
DI void g_store(u16* sWs, u16* sXs, const u32x4 (&rw)[4], const u32x4 (&rx)[4]) {
#pragma unroll
  for (int i = 0; i < 4; ++i) {
    *(u32x4*)(sWs + i * 32 * 64) = rw[i];
    *(u32x4*)(sXs + i * 32 * 64) = rx[i];
  }
}
DI void g_compute(f32x4 (&acc)[4][4], const u16* cw, const u16* cx, int c0) {
  bf16x8 a0[4], b0[4], a1[4], b1[4];
#pragma unroll
  for (int i = 0; i < 4; ++i) { a0[i] = *(const bf16x8*)(cw + i * 16 * 64 + c0); b0[i] = *(const bf16x8*)(cx + i * 16 * 64 + c0); }
#pragma unroll
  for (int i = 0; i < 4; ++i) { a1[i] = *(const bf16x8*)(cw + i * 16 * 64 + (c0 ^ 32)); b1[i] = *(const bf16x8*)(cx + i * 16 * 64 + (c0 ^ 32)); }
#pragma unroll
  for (int ni = 0; ni < 4; ++ni)
#pragma unroll
    for (int mi = 0; mi < 4; ++mi) acc[ni][mi] = MFMA16(a0[ni], b0[mi], acc[ni][mi]);
#pragma unroll
  for (int ni = 0; ni < 4; ++ni)
#pragma unroll
    for (int mi = 0; mi < 4; ++mi) acc[ni][mi] = MFMA16(a1[ni], b1[mi], acc[ni][mi]);
}

template <int MODE>
DI void phase_gemm(const Params& p, int l, unsigned char* smem) {
  constexpr int NT = (MODE == 0) ? 28 : 8, MT = M / 128;
  const u16* Wt = (MODE == 0) ? (const u16*)(p.ws + WS_WIN) + (size_t)l * NIN * 1024 : (const u16*)(p.ws + WS_WOUT) + (size_t)l * 1024 * 1024;
  const u16* X = (const u16*)(p.ws + WS_H);
  u16* sW = (u16*)smem;
  u16* sX = sW + 2 * 128 * 64;
  const int tid = otid(), lane = tid & 63, w = tid >> 6, wn = w & 1, wm = w >> 1, r16 = lane & 15, q = lane >> 4;
  const float* lbp = (const float*)(p.ws + WS_LB) + l * 512;
  const float* cosp = (const float*)(p.ws + WS_COS);
  const float* sinp = (const float*)(p.ws + WS_SIN);
  const int xcd = blockIdx.x & 7, slot = blockIdx.x >> 3, nslots = gridDim.x >> 3;
  constexpr int PER_XCD = 34 * NT, NG = (MODE == 0) ? 7 : 8;
  for (int ti = slot; ti < PER_XCD; ti += nslots) {
    const int g = ti / (34 * NG), r = ti % (34 * NG), ml = r / NG, nl = r % NG;
    const int nt = g * NG + nl, mt = xcd * 34 + ml, n0 = nt * 128, m0 = mt * 128;
    f32x4 acc[4][4];
#pragma unroll
    for (int a = 0; a < 4; ++a)
#pragma unroll
      for (int b2 = 0; b2 < 4; ++b2) acc[a][b2] = (f32x4){0.f, 0.f, 0.f, 0.f};
    const int srow = tid >> 3, scc = tid & 7;
    const u16* Wp = Wt + (size_t)n0 * 1024;
    const u16* Xp = X + (size_t)m0 * 1024;
    const unsigned goff = (unsigned)(srow * 1024 + scc * 8);
    u16* sWs = sW + srow * 64 + ((scc ^ (srow & 7)) * 8);
    u16* sXs = sX + srow * 64 + ((scc ^ (srow & 7)) * 8);
    const u16* cw = sW + (wn * 64 + r16) * 64;
    const u16* cx = sX + (wm * 64 + r16) * 64;
    const int c0 = (q ^ (r16 & 7)) * 8;
    u32x4 r0w[4], r0x[4], r1w[4], r1x[4];
    g_load(r0w, r0x, Wp, Xp, goff);
    g_load(r1w, r1x, Wp, Xp, goff + 64u);
    g_store(sWs, sXs, r0w, r0x);
    g_load(r0w, r0x, Wp, Xp, goff + 128u);
    __syncthreads();
#pragma unroll 1
    for (int ks = 0; ks < 16; ks += 2) {
      g_store(sWs + 128 * 64, sXs + 128 * 64, r1w, r1x);
      if (ks + 3 < 16) g_load(r1w, r1x, Wp, Xp, goff + (unsigned)(ks + 3) * 64u);
      g_compute(acc, cw, cx, c0);
      __syncthreads();
      if (ks + 2 < 16) g_store(sWs, sXs, r0w, r0x);
      if (ks + 4 < 16) g_load(r0w, r0x, Wp, Xp, goff + (unsigned)(ks + 4) * 64u);
      g_compute(acc, cw + 128 * 64, cx + 128 * 64, c0);
      __syncthreads();
    }
    if (MODE == 1) {
      u16* O = (u16*)(p.ws + WS_U);
      u16* hT = (u16*)smem;
#pragma unroll
      for (int mi = 0; mi < 4; ++mi) {
        int ml = wm * 64 + mi * 16 + r16;
#pragma unroll
        for (int ni = 0; ni < 4; ++ni) {
          int nl2 = wn * 64 + ni * 16 + q * 4;
          *(uint2*)(hT + ml * 136 + nl2) = make_uint2(pk(acc[ni][mi][0], acc[ni][mi][1]), pk(acc[ni][mi][2], acc[ni][mi][3]));
        }
      }
      __syncthreads();
#pragma unroll
      for (int j = 0; j < 8; ++j) {
        int id = tid + 256 * j, row = id >> 4, c = id & 15;
        *(uint4*)(O + (size_t)(m0 + row) * 1024 + n0 + c * 8) = *(const uint4*)(hT + row * 136 + c * 8);
      }
      __syncthreads();
    } else {
      u16* U = (u16*)(p.ws + WS_U);
      const int slice = n0 >> 8;
#pragma unroll
      for (int mi = 0; mi < 4; ++mi) {
        int m = m0 + wm * 64 + mi * 16 + r16;
        int b = m / T, t = m - b * T;
        u16* urow = (u16*)smem + (wm * 64 + mi * 16 + r16) * 136 + wn * 64 + q * 4;
        if (slice == 10 || slice == 11) {
          bool rot = t >= LCTX;
          float4 cs = make_float4(1.f, 1.f, 1.f, 1.f), sn = make_float4(0.f, 0.f, 0.f, 0.f);
          if (rot) { cs = *(const float4*)(cosp + (t - LCTX) * 16 + q * 4); sn = *(const float4*)(sinp + (t - LCTX) * 16 + q * 4); }
          float sc = (slice == 10) ? QSCALE : 1.f;
          float csv[4] = {cs.x, cs.y, cs.z, cs.w}, snv[4] = {sn.x, sn.y, sn.z, sn.w};
#pragma unroll
          for (int hp = 0; hp < 2; ++hp) {
            float o1[4], o2[4];
#pragma unroll
            for (int i = 0; i < 4; ++i) {
              float x1 = acc[2 * hp][mi][i], x2 = acc[2 * hp + 1][mi][i];
              o1[i] = (x1 * csv[i] - x2 * snv[i]) * sc;
              o2[i] = (x1 * snv[i] + x2 * csv[i]) * sc;
            }
            *(uint2*)(urow + (2 * hp) * 16) = make_uint2(pk(o1[0], o1[1]), pk(o1[2], o1[3]));
            *(uint2*)(urow + (2 * hp + 1) * 16) = make_uint2(pk(o2[0], o2[1]), pk(o2[2], o2[3]));
          }
        } else {
#pragma unroll
          for (int ni = 0; ni < 4; ++ni) {
            float v[4];
#pragma unroll
            for (int i = 0; i < 4; ++i) v[i] = acc[ni][mi][i];
            if (slice == 1 || slice == 2 || slice == 6 || slice == 9 || slice == 13) {
#pragma unroll
              for (int i = 0; i < 4; ++i) v[i] = silu(v[i]);
            } else if (slice == 8) {
#pragma unroll
              for (int i = 0; i < 4; ++i) v[i] = sigm(v[i]);
            } else if (slice == 4 || slice == 5) {
              int cidx = (n0 & 255) + wn * 64 + ni * 16 + q * 4;
              float4 lb4 = *(const float4*)(lbp + (slice - 4) * 256 + cidx);
              float lbv[4] = {lb4.x, lb4.y, lb4.z, lb4.w};
#pragma unroll
              for (int i = 0; i < 4; ++i) {
                float f = fmaxf(lbv[i], 1e-30f) + (1.f - lbv[i]) * sigm(v[i]);
                v[i] = __logf(f);
              }
            }
            *(uint2*)(urow + ni * 16) = make_uint2(pk(v[0], v[1]), pk(v[2], v[3]));
          }
        }
      }
      __syncthreads();
#pragma unroll
      for (int j = 0; j < 8; ++j) {
        int id = tid + 256 * j, row = id >> 4, c = id & 15;
        *(uint4*)(U + (size_t)(m0 + row) * NIN + n0 + c * 8) = *(const uint4*)((const u16*)smem + row * 136 + c * 8);
      }
      __syncthreads();
    }
  }
}

DI float vmax3(float a, float b, float c) { float r; asm("v_max3_f32 %0, %1, %2, %3" : "=v"(r) : "v"(a), "v"(b), "v"(c)); return r; }
DI void attn_sub(const u16* cK, const u16* cV, int shoff, int h, int r32, int tr_row, int tr_col,
                 const bf16x8& q0, const bf16x8& q1, f32x16& oa0, f32x16& oa1, float& mref, float& lrun, bool first) {
  f32x16 S0, S1;
  {
    const u16* kp = cK + r32 * 72 + shoff + 8 * h;
    bf16x8 k0 = *(const bf16x8*)(kp), k1 = *(const bf16x8*)(kp + 16);
    bf16x8 k2 = *(const bf16x8*)(kp + 32 * 72), k3 = *(const bf16x8*)(kp + 32 * 72 + 16);
    f32x16 z;
    const float nm = -mref;
#pragma unroll
    for (int i = 0; i < 16; ++i) z[i] = nm;
    S0 = MFMA32(k0, q0, z); S0 = MFMA32(k1, q1, S0);
    S1 = MFMA32(k2, q0, z); S1 = MFMA32(k3, q1, S1);
  }
  float s00 = S0[0], s10 = S1[0];
  asm volatile("s_nop 7\n\ts_nop 7\n\ts_nop 3" : "+v"(s00), "+v"(s10));
  float mx = vmax3(s00, s10, S0[1]);
#pragma unroll
  for (int i = 2; i < 16; i += 2) mx = vmax3(mx, S0[i], S0[i + 1]);
  mx = vmax3(mx, S1[1], S1[2]);
#pragma unroll
  for (int i = 3; i < 15; i += 2) mx = vmax3(mx, S1[i], S1[i + 1]);
  mx = fmaxf(mx, S1[15]);
  mx = fmaxf(mx, shx(mx, 32));
  const bool need = first || (mx > 8.f);
  if (__builtin_amdgcn_ballot_w64(need) != 0ull) {
    const float delta = first ? mx : fmaxf(mx, 0.f);
    mref += delta;
    if (!first) {
      const float al = __builtin_amdgcn_exp2f(-delta);
      lrun *= al;
#pragma unroll
      for (int i = 0; i < 16; ++i) { oa0[i] *= al; oa1[i] *= al; }
    }
#pragma unroll
    for (int i = 0; i < 16; ++i) { S0[i] -= delta; S1[i] -= delta; }
  }
  f32x2 rs2 = {0.f, 0.f};
#pragma unroll
  for (int i = 0; i < 16; i += 2) {
    S0[i] = __builtin_amdgcn_exp2f(S0[i]); S0[i + 1] = __builtin_amdgcn_exp2f(S0[i + 1]);
    S1[i] = __builtin_amdgcn_exp2f(S1[i]); S1[i + 1] = __builtin_amdgcn_exp2f(S1[i + 1]);
    f32x2 a2 = {S0[i], S0[i + 1]}, b2 = {S1[i], S1[i + 1]};
    rs2 += a2; rs2 += b2;
  }
  lrun += rs2[0] + rs2[1];
#pragma unroll
  for (int s = 0; s < 2; ++s) {
    bf16x8 pb = mk8(pk(S0[8 * s], S0[8 * s + 1]), pk(S0[8 * s + 2], S0[8 * s + 3]), pk(S0[8 * s + 4], S0[8 * s + 5]), pk(S0[8 * s + 6], S0[8 * s + 7]));
    const u16* a0 = cV + (16 * s + tr_row) * 96 + tr_col;
    s16x4 lo = tr16(a0), hi = tr16(a0 + 8 * 96);
    oa0 = MFMA32(__builtin_shufflevector(lo, hi, 0, 1, 2, 3, 4, 5, 6, 7), pb, oa0);
    lo = tr16(a0 + 32); hi = tr16(a0 + 8 * 96 + 32);
    oa1 = MFMA32(__builtin_shufflevector(lo, hi, 0, 1, 2, 3, 4, 5, 6, 7), pb, oa1);
  }
#pragma unroll
  for (int s = 0; s < 2; ++s) {
    bf16x8 pb = mk8(pk(S1[8 * s], S1[8 * s + 1]), pk(S1[8 * s + 2], S1[8 * s + 3]), pk(S1[8 * s + 4], S1[8 * s + 5]), pk(S1[8 * s + 6], S1[8 * s + 7]));
    const u16* a0 = cV + (16 * (2 + s) + tr_row) * 96 + tr_col;
    s16x4 lo = tr16(a0), hi = tr16(a0 + 8 * 96);
    oa0 = MFMA32(__builtin_shufflevector(lo, hi, 0, 1, 2, 3, 4, 5, 6, 7), pb, oa0);
    lo = tr16(a0 + 32); hi = tr16(a0 + 8 * 96 + 32);
    oa1 = MFMA32(__builtin_shufflevector(lo, hi, 0, 1, 2, 3, 4, 5, 6, 7), pb, oa1);
  }
}

DI void attn_item(const Params& p, int l, int item, unsigned char* smem) {
  int b, vh, qt;
  if (item < 1024) { qt = 2 + (item & 31); vh = (item >> 5) & 3; b = item >> 7; }
  else { int i2 = item - 1024; qt = i2 & 1; vh = (i2 >> 1) & 3; b = i2 >> 3; }
  const int nkeys = (qt < 2) ? 256 : T, t0 = qt * 128, ntiles = nkeys >> 6;
  u16* sK = (u16*)smem;
  u16* sV = sK + 2 * 64 * 72;
  const int tid = otid(), lane = tid & 63, w = tid >> 6, h = lane >> 5, r32 = lane & 31;
  const u16* Ub = (const u16*)(p.ws + WS_U) + (size_t)b * T * NIN;
  const int tq = t0 + 32 * w + r32;
  const u16* qp = Ub + (size_t)tq * NIN + 10 * 256 + vh * 64;
  const bf16x8 qf00 = *(const bf16x8*)(qp + 8 * h), qf01 = *(const bf16x8*)(qp + 16 + 8 * h);
  const bf16x8 qf10 = *(const bf16x8*)(qp + 32 + 8 * h), qf11 = *(const bf16x8*)(qp + 48 + 8 * h);
  f32x16 oacc00, oacc01, oacc10, oacc11;
#pragma unroll
  for (int i = 0; i < 16; ++i) { oacc00[i] = 0.f; oacc01[i] = 0.f; oacc10[i] = 0.f; oacc11[i] = 0.f; }
  float mrun0 = 0.f, mrun1 = 0.f, lrun0 = 0.f, lrun1 = 0.f;
  const int lk0 = tid >> 3, lcc = tid & 7;
  const u16* kbase = Ub + 11 * 256 + vh * 64 + lcc * 8;
  const u16* vbase = Ub + 12 * 256 + vh * 64 + lcc * 8;
  u32x4 ak0, ak1, av0, av1, bk0, bk1, bv0, bv1;
  const size_t ro0 = (size_t)lk0 * NIN, ro1 = (size_t)(lk0 + 32) * NIN;
  ak0 = *(const u32x4*)(kbase + ro0); ak1 = *(const u32x4*)(kbase + ro1);
  av0 = *(const u32x4*)(vbase + ro0); av1 = *(const u32x4*)(vbase + ro1);
  bk0 = *(const u32x4*)(kbase + ro0 + (size_t)64 * NIN); bk1 = *(const u32x4*)(kbase + ro1 + (size_t)64 * NIN);
  bv0 = *(const u32x4*)(vbase + ro0 + (size_t)64 * NIN); bv1 = *(const u32x4*)(vbase + ro1 + (size_t)64 * NIN);
  u16* wK0 = sK + lk0 * 72 + lcc * 8;
  u16* wV0 = sV + lk0 * 96 + lcc * 8;
  __syncthreads();
  *(u32x4*)(wK0) = ak0; *(u32x4*)(wK0 + 32 * 72) = ak1; *(u32x4*)(wV0) = av0; *(u32x4*)(wV0 + 32 * 96) = av1;
  __syncthreads();
  const int g = lane >> 4, i16 = lane & 15;
  const int tr_row = 4 * (g >> 1) + (i16 >> 2), tr_col = 16 * (g & 1) + 4 * (i16 & 3);
#pragma unroll 1
  for (int kt = 0; kt < ntiles; kt += 2) {
    if (kt + 2 < ntiles) {
      const size_t o = (size_t)(kt + 2) * 64 * NIN;
      ak0 = *(const u32x4*)(kbase + ro0 + o); ak1 = *(const u32x4*)(kbase + ro1 + o);
      av0 = *(const u32x4*)(vbase + ro0 + o); av1 = *(const u32x4*)(vbase + ro1 + o);
    }
    attn_sub(sK, sV, 0, h, r32, tr_row, tr_col, qf00, qf01, oacc00, oacc01, mrun0, lrun0, kt == 0);
    attn_sub(sK, sV, 32, h, r32, tr_row, tr_col, qf10, qf11, oacc10, oacc11, mrun1, lrun1, kt == 0);
    *(u32x4*)(wK0 + 64 * 72) = bk0; *(u32x4*)(wK0 + 96 * 72) = bk1; *(u32x4*)(wV0 + 64 * 96) = bv0; *(u32x4*)(wV0 + 96 * 96) = bv1;
    __syncthreads();
    if (kt + 3 < ntiles) {
      const size_t o = (size_t)(kt + 3) * 64 * NIN;
      bk0 = *(const u32x4*)(kbase + ro0 + o); bk1 = *(const u32x4*)(kbase + ro1 + o);
      bv0 = *(const u32x4*)(vbase + ro0 + o); bv1 = *(const u32x4*)(vbase + ro1 + o);
    }
    attn_sub(sK + 64 * 72, sV + 64 * 96, 0, h, r32, tr_row, tr_col, qf00, qf01, oacc00, oacc01, mrun0, lrun0, false);
    attn_sub(sK + 64 * 72, sV + 64 * 96, 32, h, r32, tr_row, tr_col, qf10, qf11, oacc10, oacc11, mrun1, lrun1, false);
    if (kt + 2 < ntiles) { *(u32x4*)(wK0) = ak0; *(u32x4*)(wK0 + 32 * 72) = ak1; *(u32x4*)(wV0) = av0; *(u32x4*)(wV0 + 32 * 96) = av1; }
    __syncthreads();
  }
  const float* lamp = (const float*)(p.ws + WS_LAM) + l * 2;
  const float lam = lamp[0], coef = lamp[1];
  float l0 = lrun0 + shx(lrun0, 32), l1 = lrun1 + shx(lrun1, 32);
  float i0 = 1.f / l0, i1 = lam / l1;
  float ss = 0.f;
#pragma unroll
  for (int i = 0; i < 16; ++i) {
    float o = oacc00[i] * i0 - oacc10[i] * i1; oacc00[i] = o; ss += o * o;
    o = oacc01[i] * i0 - oacc11[i] * i1; oacc01[i] = o; ss += o * o;
  }
  ss += shx(ss, 32);
  float rstd = rsqrtf(ss * (1.f / 64.f) + 1e-6f) * coef;
  const size_t row = (size_t)b * T + tq;
  const u16* gp = Ub + (size_t)tq * NIN + 13 * 256 + vh * 64;
  u16* yp = (u16*)(p.ws + WS_H) + row * 1024 + 768 + vh * 64;
  const float* ng = p.diff_norm_g + l * 64;
  uint2 gva[4], gvb[4];
  float4 nga[4], ngb[4];
#pragma unroll
  for (int g4 = 0; g4 < 4; ++g4) {
    gva[g4] = *(const uint2*)(gp + 8 * g4 + 4 * h); gvb[g4] = *(const uint2*)(gp + 32 + 8 * g4 + 4 * h);
    nga[g4] = *(const float4*)(ng + 8 * g4 + 4 * h); ngb[g4] = *(const float4*)(ng + 32 + 8 * g4 + 4 * h);
  }
#pragma unroll
  for (int g4 = 0; g4 < 4; ++g4) {
    {
      int dv = 8 * g4 + 4 * h;
      const uint2 gv = gva[g4];
      const float4 n4 = nga[g4];
      float y0 = oacc00[4 * g4] * rstd * n4.x * bflo(gv.x), y1 = oacc00[4 * g4 + 1] * rstd * n4.y * bfhi(gv.x);
      float y2 = oacc00[4 * g4 + 2] * rstd * n4.z * bflo(gv.y), y3 = oacc00[4 * g4 + 3] * rstd * n4.w * bfhi(gv.y);
      *(uint2*)(yp + dv) = make_uint2(pk(y0, y1), pk(y2, y3));
    }
    {
      int dv = 32 + 8 * g4 + 4 * h;
      const uint2 gv = gvb[g4];
      const float4 n4 = ngb[g4];
      float y0 = oacc01[4 * g4] * rstd * n4.x * bflo(gv.x), y1 = oacc01[4 * g4 + 1] * rstd * n4.y * bfhi(gv.x);
      float y2 = oacc01[4 * g4 + 2] * rstd * n4.z * bflo(gv.y), y3 = oacc01[4 * g4 + 3] * rstd * n4.w * bfhi(gv.y);
      *(uint2*)(yp + dv) = make_uint2(pk(y0, y1), pk(y2, y3));
    }
  }
}

template <bool OUT, int DIR>
DI void hgrn_dir(const Params& p, int b, int hh, int c, const u16* Ub, u16* sQ, u16* sKp, u16* sKd, u16* sV, float* sDec, f32x4 (&oacc)[4]) {
  const int tid = otid(), lane = tid & 63, w = tid >> 6, q = lane >> 4, r16 = lane & 15;
  __syncthreads();
  {
    const int d = tid & 63, I = tid >> 6;
    const int gcol = (4 + DIR) * 256 + hh * 64 + d, qcol = 2 * 256 + hh * 64 + d;
    float g[16], qv[16], gc[16];
#pragma unroll
    for (int tt = 0; tt < 16; ++tt) {
      const u16* rp = Ub + (size_t)(16 * I + tt) * NIN;
      g[tt] = bf2f(rp[gcol]); qv[tt] = bf2f(rp[qcol]);
    }
    float run = 0.f;
    if (DIR == 0) {
#pragma unroll
      for (int tt = 0; tt < 16; ++tt) { run += g[tt]; gc[tt] = run; }
    } else {
#pragma unroll
      for (int tt = 15; tt >= 0; --tt) { run += g[tt]; gc[tt] = run; }
    }
#pragma unroll
    for (int tt = 0; tt < 16; ++tt) {
      float kk = 1.f - __expf(g[tt]);
      int o = (16 * I + tt) * 80 + d;
      sQ[o] = f2bf(qv[tt] * __expf(gc[tt]));
      if (OUT) sKp[o] = f2bf(kk * __expf(fminf(-gc[tt], 80.f)));
      sKd[o] = f2bf(kk * __expf(run - gc[tt]));
    }
    sDec[I * 64 + d] = __expf(run);
#pragma unroll
    for (int i = 0; i < 2; ++i) {
      int ch = tid + 256 * i, row = ch >> 3, cc = ch & 7;
      *(uint4*)(sV + row * 80 + cc * 8) = *(const uint4*)(Ub + (size_t)row * NIN + 3 * 256 + hh * 64 + cc * 8);
    }
  }
  __syncthreads();
  const int chain = (b * 4 + hh) * 2 + DIR;
  if (!OUT && tid < 64)
    ((float*)(p.ws + WS_DB))[((size_t)chain * NCH + c) * 64 + tid] = sDec[tid] * sDec[64 + tid] * sDec[128 + tid] * sDec[192 + tid];
  float* Sg = (float*)(p.ws + WS_SB) + ((size_t)chain * NCH + c) * 4096;
  f32x4 S[4];
#pragma unroll
  for (int dt = 0; dt < 4; ++dt)
#pragma unroll
    for (int i = 0; i < 4; ++i) S[dt][i] = OUT ? Sg[(16 * dt + 4 * q + i) * 64 + 16 * w + r16] : 0.f;
#pragma unroll
  for (int step = 0; step < 4; ++step) {
    constexpr int dummy = 0; (void)dummy;
    const int I = DIR ? 3 - step : step;
    const int trr = (16 * I + 4 * q + (r16 >> 2)) * 80 + 4 * (r16 & 3);
    s16x4 vfrag = tr16(sV + trr + 16 * w);
    if (OUT) {
      const u16* kpp = sKp + (16 * I + r16) * 80 + 8 * q;
      const u16* qpp = sQ + (16 * I + r16) * 80;
      f32x4 sc = (f32x4){0.f, 0.f, 0.f, 0.f};
      sc = MFMA16(*(const bf16x8*)(kpp), *(const bf16x8*)(qpp + 8 * q), sc);
      sc = MFMA16(*(const bf16x8*)(kpp + 32), *(const bf16x8*)(qpp + 32 + 8 * q), sc);
#pragma unroll
      for (int i = 0; i < 4; ++i) {
        int j = 4 * q + i;
        bool keep = DIR ? (j >= r16) : (j <= r16);
        sc[i] = keep ? sc[i] : 0.f;
      }
      s16x4 pb = mk4(pk(sc[0], sc[1]), pk(sc[2], sc[3]));
      f32x4 oT = (f32x4){0.f, 0.f, 0.f, 0.f};
      oT = MFMA16K16(vfrag, pb, oT);
#pragma unroll
      for (int a = 0; a < 2; ++a) {
        bf16x8 sA = mk8(pk(S[2 * a][0], S[2 * a][1]), pk(S[2 * a][2], S[2 * a][3]), pk(S[2 * a + 1][0], S[2 * a + 1][1]), pk(S[2 * a + 1][2], S[2 * a + 1][3]));
        s16x4 lo = *(const s16x4*)(qpp + 32 * a + 4 * q), hi = *(const s16x4*)(qpp + 32 * a + 16 + 4 * q);
        bf16x8 bq = __builtin_shufflevector(lo, hi, 0, 1, 2, 3, 4, 5, 6, 7);
        oT = MFMA16(sA, bq, oT);
      }
      oacc[I] += oT;
    }
#pragma unroll
    for (int dt = 0; dt < 4; ++dt) {
      float4 d4 = *(const float4*)(sDec + I * 64 + 16 * dt + 4 * q);
      S[dt][0] *= d4.x; S[dt][1] *= d4.y; S[dt][2] *= d4.z; S[dt][3] *= d4.w;
      s16x4 kd = tr16(sKd + trr + 16 * dt);
      S[dt] = MFMA16K16(kd, vfrag, S[dt]);
    }
  }
  if (!OUT) {
#pragma unroll
    for (int dt = 0; dt < 4; ++dt)
#pragma unroll
      for (int i = 0; i < 4; ++i) Sg[(16 * dt + 4 * q + i) * 64 + 16 * w + r16] = S[dt][i];
  }
}

template <bool OUT>
DI void hgrn_item(const Params& p, int l, int item, unsigned char* smem) {
  const int c = item % NCH, hh = (item / NCH) & 3, b = item / (NCH * 4);
  u16* sQ = (u16*)smem;
  u16* sKp = sQ + 64 * 80;
  u16* sKd = sKp + 64 * 80;
  u16* sV = sKd + 64 * 80;
  float* sDec = (float*)(sV + 64 * 80);
  float* sRed = sDec + 256;
  const int tid = otid(), lane = tid & 63, w = tid >> 6, q = lane >> 4, r16 = lane & 15;
  const size_t rowbase = (size_t)b * T + c * 64;
  const u16* Ub = (const u16*)(p.ws + WS_U) + rowbase * NIN;
  f32x4 oacc[4];
#pragma unroll
  for (int i = 0; i < 4; ++i) oacc[i] = (f32x4){0.f, 0.f, 0.f, 0.f};
  hgrn_dir<OUT, 0>(p, b, hh, c, Ub, sQ, sKp, sKd, sV, sDec, oacc);
  hgrn_dir<OUT, 1>(p, b, hh, c, Ub, sQ, sKp, sKd, sV, sDec, oacc);
  if (OUT) {
    float part[4];
#pragma unroll
    for (int I = 0; I < 4; ++I) {
      part[I] = oacc[I][0] * oacc[I][0] + oacc[I][1] * oacc[I][1] + oacc[I][2] * oacc[I][2] + oacc[I][3] * oacc[I][3];
      part[I] += shx(part[I], 16);
      part[I] += shx(part[I], 32);
      if (q == 0) sRed[w * 64 + 16 * I + r16] = part[I];
    }
    __syncthreads();
    const float* ng = p.hgrn_norm_g + l * 64;
    const int e0 = 16 * w + 4 * q;
    float4 n4 = *(const float4*)(ng + e0);
    uint2 gvs[4];
#pragma unroll
    for (int I = 0; I < 4; ++I) gvs[I] = *(const uint2*)(Ub + (size_t)(16 * I + r16) * NIN + 6 * 256 + hh * 64 + e0);
#pragma unroll
    for (int I = 0; I < 4; ++I) {
      int t = 16 * I + r16;
      float tot = sRed[t] + sRed[64 + t] + sRed[128 + t] + sRed[192 + t];
      float rstd = rsqrtf(tot * (1.f / 64.f) + 1e-6f);
      const uint2 gv = gvs[I];
      float y0 = oacc[I][0] * rstd * n4.x * bflo(gv.x), y1 = oacc[I][1] * rstd * n4.y * bfhi(gv.x);
      float y2 = oacc[I][2] * rstd * n4.z * bflo(gv.y), y3 = oacc[I][3] * rstd * n4.w * bfhi(gv.y);
      *(uint2*)((u16*)(p.ws + WS_H) + (rowbase + t) * 1024 + 256 + hh * 64 + e0) = make_uint2(pk(y0, y1), pk(y2, y3));
    }
  }
}

DI void hgrn_scan_item(const Params& p, int item) {
  const int chain = item >> 3, slab = item & 7, dir = chain & 1;
  const int elem = slab * 512 + otid();
  float* Sb = (float*)(p.ws + WS_SB) + (size_t)chain * NCH * 4096 + elem;
  const float* Db = (const float*)(p.ws + WS_DB) + (size_t)chain * NCH * 64;
  const int d0 = elem >> 6, d1 = (elem + 256) >> 6;
  float run0 = 0.f, run1 = 0.f;
#pragma unroll 1
  for (int s0 = 0; s0 < NCH; s0 += 17) {
    float t0[17], t1[17], e0[17], e1[17];
#pragma unroll
    for (int j = 0; j < 17; ++j) {
      const int s = s0 + j;
      const int c = dir == 0 ? s : (s < 4 ? 3 - s : 71 - s);
      t0[j] = Sb[(size_t)c * 4096]; t1[j] = Sb[(size_t)c * 4096 + 256];
      e0[j] = Db[c * 64 + d0]; e1[j] = Db[c * 64 + d1];
    }
#pragma unroll
    for (int j = 0; j < 17; ++j) {
      const int s = s0 + j;
      const int c = dir == 0 ? s : (s < 4 ? 3 - s : 71 - s);
      Sb[(size_t)c * 4096] = run0; Sb[(size_t)c * 4096 + 256] = run1;
      run0 = e0[j] * run0 + t0[j]; run1 = e1[j] * run1 + t1[j];
    }
  }
}

template <bool FINAL, int DIR>
DI void lru_dir(const Params& p, int l, size_t rowb, int tb, int b, int c, const u16* sX, f32x2* sAU, float hcar, float (&hf)[64]) {
  const int tid = otid(), lane = tid & 63, w = tid >> 6, q = lane >> 4, r16 = lane & 15;
  const int ch = 64 * w + lane;
  const u16* U = (const u16*)(p.ws + WS_U);
  const u16* Wr = (const u16*)(p.ws + WS_WL) + (size_t)((((l * 2 + DIR) * 2 + 0) * 4 + w)) * 4096;
  const u16* Wi = (const u16*)(p.ws + WS_WL) + (size_t)((((l * 2 + DIR) * 2 + 1) * 4 + w)) * 4096;
  bf16x8 ar[4][2], ai[4][2];
#pragma unroll
  for (int jt = 0; jt < 4; ++jt)
#pragma unroll
    for (int ks = 0; ks < 2; ++ks) {
      ar[jt][ks] = *(const bf16x8*)(Wr + (16 * jt + r16) * 64 + 32 * ks + 8 * q);
      ai[jt][ks] = *(const bf16x8*)(Wi + (16 * jt + r16) * 64 + 32 * ks + 8 * q);
    }
  const float* brp = p.lru_b_r + (l * 2 + DIR) * 256 + 64 * w + 4 * q;
  const float* bip = p.lru_b_i + (l * 2 + DIR) * 256 + 64 * w + 4 * q;
  const float* lmp = p.lru_lambda + (l * 2 + DIR) * 256 + 64 * w + 4 * q;
  float spv[4][4];
#pragma unroll
  for (int jt = 0; jt < 4; ++jt) {
    float4 lm4 = *(const float4*)(lmp + 16 * jt);
    spv[jt][0] = log1pf(__expf(-lm4.x)); spv[jt][1] = log1pf(__expf(-lm4.y)); spv[jt][2] = log1pf(__expf(-lm4.z)); spv[jt][3] = log1pf(__expf(-lm4.w));
  }
  float h = hcar, aprod = 1.f;
#pragma unroll
  for (int s = 0; s < 4; ++s) {
    const int tt = DIR ? 3 - s : s;
    bf16x8 bx0 = *(const bf16x8*)(sX + (16 * tt + r16) * 272 + 64 * w + 8 * q);
    bf16x8 bx1 = *(const bf16x8*)(sX + (16 * tt + r16) * 272 + 64 * w + 32 + 8 * q);
#pragma unroll
    for (int jt = 0; jt < 4; ++jt) {
      f32x4 accr = (f32x4){0.f, 0.f, 0.f, 0.f}, acci = (f32x4){0.f, 0.f, 0.f, 0.f};
      accr = MFMA16(ar[jt][0], bx0, accr); accr = MFMA16(ar[jt][1], bx1, accr);
      acci = MFMA16(ai[jt][0], bx0, acci); acci = MFMA16(ai[jt][1], bx1, acci);
      float4 br4 = *(const float4*)(brp + 16 * jt), bi4 = *(const float4*)(bip + 16 * jt);
      float brv[4] = {br4.x, br4.y, br4.z, br4.w}, biv[4] = {bi4.x, bi4.y, bi4.z, bi4.w};
      uint2 xc2 = *(const uint2*)(sX + (16 * tt + r16) * 272 + 64 * w + 16 * jt + 4 * q);
      float xcv[4] = {bflo(xc2.x), bfhi(xc2.x), bflo(xc2.y), bfhi(xc2.y)};
#pragma unroll
      for (int i = 0; i < 4; ++i) {
        float r = sigm(accr[i] + brv[i]), ig = sigm(acci[i] + biv[i]);
        float la = -8.f * r * spv[jt][i];
        float a = __expf(la);
        float mult = __builtin_amdgcn_sqrtf(fmaxf((1.f - a) * (1.f + a), 0.f));
        f32x2 au = {a, mult * ig * xcv[i]};
        sAU[(w * 64 + 16 * jt + 4 * q + i) * 17 + r16] = au;
      }
    }
    __syncthreads();
    u16 gt[16];
    if (FINAL && DIR == 1) {
#pragma unroll
      for (int step = 0; step < 16; ++step) gt[step] = U[(rowb + tb + 16 * tt + (15 - step)) * NIN + 256 + ch];
    }
#pragma unroll
    for (int step = 0; step < 16; ++step) {
      const int tl = DIR ? 15 - step : step;
      f32x2 au = sAU[(w * 64 + lane) * 17 + tl];
      h = au.x * h + au.y;
      if (FINAL) {
        if (DIR == 0) hf[16 * tt + tl] = h;
        else {
          const int t = 16 * tt + tl;
          float y = hf[t] + h;
          ((u16*)(p.ws + WS_H))[(rowb + tb + t) * 1024 + ch] = f2bf(y * bf2f(gt[step]));
        }
      } else aprod *= au.x;
    }
    __syncthreads();
  }
  if (!FINAL) {
    f32x2 o = {aprod, h};
    ((f32x2*)(p.ws + WS_LS))[((size_t)(b * 2 + DIR) * NCH + c) * 256 + ch] = o;
  }
}

DI float lru_chain(const f32x2* L, int start, int step, int n, float hh) {
  for (int k0 = 0; k0 < n; k0 += 16) {
    f32x2 v[16];
#pragma unroll
    for (int j = 0; j < 16; ++j) {
      const int k = k0 + j;
      v[j] = (f32x2){1.f, 0.f};
      if (k < n) v[j] = L[(size_t)(start + k * step) * 256];
    }
#pragma unroll
    for (int j = 0; j < 16; ++j) hh = v[j].x * hh + v[j].y;
  }
  return hh;
}

template <bool FINAL>
DI void lru_item(const Params& p, int l, int item, unsigned char* smem) {
  const int b = item / NCH, c = item % NCH;
  const int seg_lo = c < 4 ? 0 : LCTX, seg_hi = c < 4 ? LCTX : T, tb = c * 64;
  u16* sX = (u16*)smem;
  f32x2* sAU = (f32x2*)(smem + 64 * 272 * 2);
  const int tid = otid(), lane = tid & 63, w = tid >> 6;
  const u16* U = (const u16*)(p.ws + WS_U);
  const size_t rowb = (size_t)b * T;
  __syncthreads();
  {
    const int c4 = (tid & 63) * 4, tg = tid >> 6;
    float4 wk[4];
#pragma unroll
    for (int k = 0; k < 4; ++k) wk[k] = *(const float4*)(p.lru_conv_w + (l * 4 + k) * 256 + c4);
    float4 bias = *(const float4*)(p.lru_conv_b + l * 256 + c4);
    uint2 xr[19];
#pragma unroll
    for (int n = 0; n < 19; ++n) {
      int ts = tb + tg * 16 - 2 + n;
      xr[n] = make_uint2(0u, 0u);
      if (ts >= seg_lo && ts < seg_hi) xr[n] = *(const uint2*)(U + (rowb + ts) * NIN + c4);
    }
#pragma unroll
    for (int tt = 0; tt < 16; ++tt) {
      float o0 = bias.x, o1 = bias.y, o2 = bias.z, o3 = bias.w;
#pragma unroll
      for (int k = 0; k < 4; ++k) {
        o0 += wk[k].x * bflo(xr[tt + k].x); o1 += wk[k].y * bfhi(xr[tt + k].x); o2 += wk[k].z * bflo(xr[tt + k].y); o3 += wk[k].w * bfhi(xr[tt + k].y);
      }
      *(uint2*)(sX + (tg * 16 + tt) * 272 + c4) = make_uint2(pk(o0, o1), pk(o2, o3));
    }
  }
  __syncthreads();
  const int ch = 64 * w + lane;
  const f32x2* LSr = (const f32x2*)(p.ws + WS_LS);
  float hcar0 = 0.f, hcar1 = 0.f;
  if (FINAL) {
    const f32x2* L0 = LSr + ((size_t)(b * 2 + 0) * NCH) * 256 + ch;
    hcar0 = lru_chain(L0, 0, 1, c, 0.f);
    const f32x2* L1 = LSr + ((size_t)(b * 2 + 1) * NCH) * 256 + ch;
    float hh = 0.f;
    if (c < 4) hh = lru_chain(L1, 3, -1, 3 - c, 0.f);
    else { hh = lru_chain(L1, 3, -1, 4, 0.f); hh = lru_chain(L1, NCH - 1, -1, NCH - 1 - c, hh); }
    hcar1 = hh;
  }
  float hf[64];
  lru_dir<FINAL, 0>(p, l, rowb, tb, b, c, sX, sAU, hcar0, hf);
  lru_dir<FINAL, 1>(p, l, rowb, tb, b, c, sX, sAU, hcar1, hf);
}

DI void conf_item(const Params& p, int l, int item, unsigned char* smem) {
  const int b = item / NCH, c = item % NCH;
  const int seg_lo = c < 4 ? 0 : LCTX, seg_hi = c < 4 ? LCTX : T, tb = c * 64;
  float* sC = (float*)smem;
  const int tid = otid(), lane = tid & 63, w = tid >> 6, ch = tid;
  const u16* U = (const u16*)(p.ws + WS_U);
  const size_t rowb = (size_t)b * T;
  float wk[31], win[31];
#pragma unroll
  for (int k = 0; k < 31; ++k) { wk[k] = p.conf_conv_w[(l * 31 + k) * 256 + ch]; win[k] = 0.f; }
  const float bias = p.conf_conv_b[l * 256 + ch];
  __syncthreads();
  for (int base = 0; base < 94; base += 31) {
#pragma unroll
    for (int i = 0; i < 31; ++i) {
      const int n = base + i;
      if (n < 94) {
        const int ts = tb - 15 + n;
        float y = 0.f;
        if (ts >= seg_lo && ts < seg_hi) {
          const u16* rp = U + (rowb + ts) * NIN;
          y = bf2f(rp[7 * 256 + ch]) * bf2f(rp[8 * 256 + ch]);
        }
        win[i] = y;
        if (n >= 30) {
          float acc = bias;
#pragma unroll
          for (int k = 0; k < 31; ++k) acc += wk[k] * win[(i + 1 + k) % 31];
          sC[(n - 30) * 256 + ch] = acc;
        }
      }
    }
  }
  __syncthreads();
  float4 g4 = *(const float4*)(p.conf_ln_g + l * 256 + 4 * lane), b4 = *(const float4*)(p.conf_ln_b + l * 256 + 4 * lane);
  uint2 gts[16];
#pragma unroll
  for (int rr = 0; rr < 16; ++rr) gts[rr] = *(const uint2*)(U + (rowb + tb + w * 16 + rr) * NIN + 9 * 256 + 4 * lane);
#pragma unroll
  for (int rr = 0; rr < 16; ++rr) {
    const int t = w * 16 + rr;
    float4 v = *(const float4*)(sC + t * 256 + 4 * lane);
    float s = wave_sum(v.x + v.y + v.z + v.w);
    float mu = s * (1.f / 256.f);
    float d0 = v.x - mu, d1 = v.y - mu, d2 = v.z - mu, d3 = v.w - mu;
    float var = wave_sum(d0 * d0 + d1 * d1 + d2 * d2 + d3 * d3) * (1.f / 256.f);
    float rstd = rsqrtf(var + 1e-5f);
    const uint2 gv = gts[rr];
    float y0 = silu(d0 * rstd * g4.x + b4.x) * bflo(gv.x), y1 = silu(d1 * rstd * g4.y + b4.y) * bfhi(gv.x);
    float y2 = silu(d2 * rstd * g4.z + b4.z) * bflo(gv.y), y3 = silu(d3 * rstd * g4.w + b4.w) * bfhi(gv.y);
    *(uint2*)((u16*)(p.ws + WS_H) + (rowb + tb + t) * 1024 + 512 + 4 * lane) = make_uint2(pk(y0, y1), pk(y2, y3));
  }
}


__global__ void __launch_bounds__(256, 2) fwd_megakernel(Params p) {
  extern __shared__ __attribute__((aligned(16))) unsigned char smem[];
  __shared__ int s_item;
  __shared__ uint4 xb_words;
  cg::grid_group grid = cg::this_grid();
  unsigned* ctr = (unsigned*)(p.ws + WS_CTL);
  const int tid = otid();
  if (tid == 0) xb_words = make_uint4(0u, 0u, 0u, 0u);
  __syncthreads();
  (void)xcd_barrier_post((unsigned*)(p.ws + WS_CTL + 4096), (volatile LAS unsigned*)&xb_words);
  grid.sync();

  phase_prologue(p, smem);
  xcd_barrier((unsigned*)(p.ws + WS_CTL + 4096), (volatile LAS unsigned*)&xb_words);
  for (int l = 0; l < DEPTH; ++l) {
    phase_norm(p, l);
    xcd_barrier((unsigned*)(p.ws + WS_CTL + 4096), (volatile LAS unsigned*)&xb_words);
    phase_gemm<0>(p, l, smem);
    xcd_barrier((unsigned*)(p.ws + WS_CTL + 4096), (volatile LAS unsigned*)&xb_words);
    {
      constexpr int N_ATT = 1088, N_HG = 2176, N_LRU = 544, N_CONF = 544, TOTAL = N_ATT + N_HG + N_LRU + N_CONF;
      for (;;) {
        __syncthreads();
        if (tid == 0) s_item = (int)atomicAdd(&ctr[l * 2], 1u);
        __syncthreads();
        int it = s_item;
        if (it >= TOTAL) break;
        if (it < N_ATT) attn_item(p, l, it, smem);
        else if (it < N_ATT + N_LRU) lru_item<false>(p, l, it - N_ATT, smem);
        else if (it < N_ATT + N_LRU + N_CONF) conf_item(p, l, it - N_ATT - N_LRU, smem);
        else hgrn_item<false>(p, l, it - N_ATT - N_LRU - N_CONF, smem);
      }
    }
    xcd_barrier((unsigned*)(p.ws + WS_CTL + 4096), (volatile LAS unsigned*)&xb_words);
    for (int it = blockIdx.x; it < 512; it += gridDim.x) hgrn_scan_item(p, it);
    xcd_barrier((unsigned*)(p.ws + WS_CTL + 4096), (volatile LAS unsigned*)&xb_words);
    {
      constexpr int N_LRU = 544, TOTAL = N_LRU + 2176;
      for (;;) {
        __syncthreads();
        if (tid == 0) s_item = (int)atomicAdd(&ctr[l * 2 + 1], 1u);
        __syncthreads();
        int it = s_item;
        if (it >= TOTAL) break;
        if (it < N_LRU) lru_item<true>(p, l, it, smem);
        else hgrn_item<true>(p, l, it - N_LRU, smem);
      }
    }
    xcd_barrier((unsigned*)(p.ws + WS_CTL + 4096), (volatile LAS unsigned*)&xb_words);
    phase_gemm<1>(p, l, smem);
    xcd_barrier((unsigned*)(p.ws + WS_CTL + 4096), (volatile LAS unsigned*)&xb_words);
  }
  phase_norm(p, DEPTH);
}

extern "C" void kernel_launch(void* const* d_in, const int* in_sizes, int n_in, void* d_out, int out_size, void* d_ws, size_t ws_size,
                              hipStream_t stream) {
  static int grid_blocks = 0;
  if (grid_blocks == 0) {
    int dev = 0, cus = 0, per_cu = 0;
    hipGetDevice(&dev);
    hipDeviceGetAttribute(&cus, hipDeviceAttributeMultiprocessorCount, dev);
    if (hipFuncSetAttribute((const void*)fwd_megakernel, hipFuncAttributeMaxDynamicSharedMemorySize, LDS_BYTES) != hipSuccess) {
      fprintf(stderr, "kernel_launch: hipFuncSetAttribute failed\n");
    }
    hipOccupancyMaxActiveBlocksPerMultiprocessor(&per_cu, (const void*)fwd_megakernel, 256, LDS_BYTES);
    if (per_cu > 2) per_cu = 2;
    if (per_cu < 1) { fprintf(stderr, "kernel_launch: occupancy query returned %d\n", per_cu); per_cu = 1; }
    grid_blocks = cus * per_cu;
    if (ws_size < WS_END) fprintf(stderr, "kernel_launch: workspace too small: %zu < %zu\n", ws_size, (size_t)WS_END);
  }
  Params p{};
  const float** pp = (const float**)&p;
  for (int i = 0; i < 28; ++i) pp[i] = (const float*)d_in[i];
  p.out = (float*)d_out;
  p.ws = (unsigned char*)d_ws;
  hipMemsetAsync((char*)d_ws + WS_CTL, 0, 65536, stream);
  void* args[] = {&p};
  hipError_t e = hipLaunchCooperativeKernel((const void*)fwd_megakernel, dim3(grid_blocks), dim3(256), args, LDS_BYTES, stream);
  if (e != hipSuccess) fprintf(stderr, "cooperative launch failed: %s (grid %d)\n", hipGetErrorString(e), grid_blocks);
}
```
